# Optimizing an MI355X kernel written in HIP

```python
import jax, jax.numpy as jnp
from jax import lax
import numpy as np

D_MODEL = 2048
BATCH = 1
SEQ = 16384
DEPTH = 2

N_HEADS = 16
HEAD_DIM = D_MODEL // N_HEADS
ROPE_DIM = HEAD_DIM // 4
ROPE_THETA = 500000.0
DIL_BRANCHES = ((128, 1), (512, 4), (2048, 16))
ATT_BLOCK = 128
CONV_WIDTH = 3
CONV_DIM = D_MODEL // 2
POOL_DIM = D_MODEL // 2
POOL_WINDOWS = (2, 4, 8, 16)
POOL_GROUPS = len(POOL_WINDOWS)
POOL_GROUP = POOL_DIM // POOL_GROUPS
MIX_IN = 3 * CONV_DIM + POOL_DIM
D_FF = 256 * ((8 * D_MODEL // 3 + 255) // 256)
N_EVEN = (DEPTH + 1) // 2
N_ODD = DEPTH // 2
RMS_EPS = 1e-6
NEG_INF = -1e30

kernel_name = "hybrid_conv_pool_dilated_attn_macaron"


def rms_norm(x, g):
    xf = x.astype(jnp.float32)
    y = xf * lax.rsqrt(jnp.mean(xf * xf, axis=-1, keepdims=True) + RMS_EPS)
    return (y * g.astype(jnp.float32)).astype(x.dtype)


def swiglu(x, w1, w3, w2):
    return (jax.nn.silu(x @ w1) * (x @ w3)) @ w2


def rope_tables(positions):
    inv = ROPE_THETA ** (-jnp.arange(0, ROPE_DIM, 2, dtype=jnp.float32) / ROPE_DIM)
    ang = positions.astype(jnp.float32)[..., None] * inv
    return jnp.cos(ang)[:, :, None, :], jnp.sin(ang)[:, :, None, :]


def apply_rope(t, cos, sin):
    tr = t[..., :ROPE_DIM].astype(jnp.float32)
    x1, x2 = tr[..., :ROPE_DIM // 2], tr[..., ROPE_DIM // 2:]
    rot = jnp.concatenate([x1 * cos - x2 * sin, x2 * cos + x1 * sin], axis=-1)
    return jnp.concatenate([rot.astype(t.dtype), t[..., ROPE_DIM:]], axis=-1)


def pool_mixer(u, pool_w, pool_scale):
    B, S, _ = u.shape
    ug = u.reshape(B, S, POOL_GROUPS, POOL_GROUP).astype(jnp.float32)
    cs = jnp.cumsum(ug, axis=1)
    t = jnp.arange(S)
    outs = []
    for g, w in enumerate(POOL_WINDOWS):
        c = cs[:, :, g]
        lag = jnp.pad(c, ((0, 0), (w, 0), (0, 0)))[:, :S]
        cnt = jnp.minimum(t + 1, w).astype(jnp.float32)[None, :, None]
        outs.append((c - lag) / cnt - ug[:, :, g])
    pooled = jnp.stack(outs, axis=2).astype(u.dtype)
    mixed = jnp.einsum('bsgc,gcd->bsgd', pooled, pool_w)
    return mixed.reshape(B, S, POOL_DIM) * pool_scale


def conv_pool_mixer(h, w_in, conv_w, pool_w, pool_scale, w_out):
    z = h @ w_in
    gate_b, gate_c, hv, u = jnp.split(z, [CONV_DIM, 2 * CONV_DIM, 3 * CONV_DIM], axis=-1)
    cx = gate_c * hv
    conv = lax.conv_general_dilated(
        cx, conv_w[:, None, :].astype(cx.dtype), window_strides=(1,),
        padding=[(CONV_WIDTH - 1, 0)], dimension_numbers=('NWC', 'WIO', 'NWC'),
        feature_group_count=CONV_DIM)
    y_a = gate_b * conv
    y_b = pool_mixer(u, pool_w, pool_scale)
    return jnp.concatenate([y_a, y_b], axis=-1) @ w_out


def dilated_branch(q, k, v, dil, span):
    B, S, H, E = q.shape
    L = S // dil
    Lp = -(-L // ATT_BLOCK) * ATT_BLOCK
    nb = Lp // ATT_BLOCK

    def to_blocks(t):
        t = t.reshape(B, L, dil, H, E).transpose(0, 2, 1, 3, 4)
        t = jnp.pad(t, ((0, 0), (0, 0), (0, Lp - L), (0, 0), (0, 0)))
        return t.reshape(B, dil, nb, ATT_BLOCK, H, E)

    def with_prev(t):
        prev = jnp.pad(t, ((0, 0), (0, 0), (1, 0), (0, 0), (0, 0), (0, 0)))[:, :, :-1]
        return jnp.concatenate([prev, t], axis=3)

    qb = to_blocks(q)
    kk = with_prev(to_blocks(k))
    vv = with_prev(to_blocks(v))
    s = jnp.einsum('brnqhe,brnkhe->brnhqk', qb, kk,
                   preferred_element_type=jnp.float32) * (1.0 / np.sqrt(HEAD_DIM))
    a = jnp.arange(ATT_BLOCK)[None, :, None]
    c = jnp.arange(2 * ATT_BLOCK)[None, None, :]
    blk = jnp.arange(nb)[:, None, None]
    dist = a + ATT_BLOCK - c
    valid = (dist >= 0) & (dist <= span) & ((blk > 0) | (c >= ATT_BLOCK))
    s = jnp.where(valid[None, None, :, None], s, NEG_INF)
    m = jnp.max(s, axis=-1, keepdims=True)
    p = jnp.exp(s - m)
    l = jnp.sum(p, axis=-1, keepdims=True)
    o = jnp.einsum('brnhqk,brnkhe->brnqhe', p, vv.astype(jnp.float32))
    o = o / jnp.transpose(l[..., 0], (0, 1, 2, 4, 3))[..., None]
    lse = jnp.transpose((m + jnp.log(l))[..., 0], (0, 1, 2, 4, 3))
    o = o.reshape(B, dil, Lp, H, E)[:, :, :L].transpose(0, 2, 1, 3, 4).reshape(B, S, H, E)
    lse = lse.reshape(B, dil, Lp, H)[:, :, :L].transpose(0, 2, 1, 3).reshape(B, S, H)
    return o, lse


def dilated_attention(h, w_qkv, w_o, cos, sin):
    B, S, _ = h.shape
    qkv = (h @ w_qkv).reshape(B, S, 3, N_HEADS, HEAD_DIM)
    q = apply_rope(qkv[:, :, 0], cos, sin)
    k = apply_rope(qkv[:, :, 1], cos, sin)
    v = qkv[:, :, 2]
    outs, lses = [], []
    for window, dil in DIL_BRANCHES:
        o, lse = dilated_branch(q, k, v, dil, window // dil)
        outs.append(o)
        lses.append(lse)
    wts = jax.nn.softmax(jnp.stack(lses, axis=0), axis=0)
    o = jnp.einsum('gbsh,gbshe->bshe', wts, jnp.stack(outs, axis=0))
    return o.astype(h.dtype).reshape(B, S, D_MODEL) @ w_o


def setup_inputs(seed: int = 0) -> dict:
    key = jax.random.key(seed)
    ks = jax.random.split(key, 16)
    f32 = jnp.float32
    nrm = lambda k, shape, scale: jax.random.normal(k, shape, f32) * scale
    x = jax.random.normal(ks[0], (BATCH, SEQ, D_MODEL), f32)
    offset = jax.random.randint(ks[1], (BATCH, 1), 0, 4096, dtype=jnp.int32)
    positions = offset + jnp.arange(SEQ, dtype=jnp.int32)[None, :]
    return {
        "x": x,
        "positions": positions,
        "norm_g": 1.0 + nrm(ks[2], (DEPTH, 3, D_MODEL), 0.02),
        "ffn_w1": nrm(ks[3], (DEPTH, 2, D_MODEL, D_FF), D_MODEL ** -0.5),
        "ffn_w3": nrm(ks[4], (DEPTH, 2, D_MODEL, D_FF), D_MODEL ** -0.5),
        "ffn_w2": nrm(ks[5], (DEPTH, 2, D_FF, D_MODEL), D_FF ** -0.5),
        "mix_w_in": nrm(ks[6], (N_EVEN, D_MODEL, MIX_IN), D_MODEL ** -0.5),
        "conv_w": nrm(ks[7], (N_EVEN, CONV_WIDTH, CONV_DIM), CONV_WIDTH ** -0.5),
        "pool_w": nrm(ks[8], (N_EVEN, POOL_GROUPS, POOL_GROUP, POOL_GROUP), POOL_GROUP ** -0.5),
        "pool_scale": 1.0 + nrm(ks[9], (N_EVEN, POOL_DIM), 0.02),
        "mix_w_out": nrm(ks[10], (N_EVEN, D_MODEL, D_MODEL), D_MODEL ** -0.5),
        "attn_w_qkv": nrm(ks[11], (N_ODD, D_MODEL, 3 * D_MODEL), D_MODEL ** -0.5),
        "attn_w_o": nrm(ks[12], (N_ODD, D_MODEL, D_MODEL), D_MODEL ** -0.5),
        "final_g": 1.0 + nrm(ks[13], (D_MODEL,), 0.02),
    }


def reference(x, positions, norm_g, ffn_w1, ffn_w3, ffn_w2, mix_w_in, conv_w, pool_w,
              pool_scale, mix_w_out, attn_w_qkv, attn_w_o, final_g):
    cos, sin = rope_tables(positions)
    h = x
    for i in range(DEPTH):
        h = h + 0.5 * swiglu(rms_norm(h, norm_g[i, 0]), ffn_w1[i, 0], ffn_w3[i, 0], ffn_w2[i, 0])
        hn = rms_norm(h, norm_g[i, 1])
        j = i // 2
        if i % 2 == 0:
            h = h + conv_pool_mixer(hn, mix_w_in[j], conv_w[j], pool_w[j], pool_scale[j], mix_w_out[j])
        else:
            h = h + dilated_attention(hn, attn_w_qkv[j], attn_w_o[j], cos, sin)
        h = h + 0.5 * swiglu(rms_norm(h, norm_g[i, 2]), ffn_w1[i, 1], ffn_w3[i, 1], ffn_w2[i, 1])
    return rms_norm(h, final_g)
```

```cpp
#include <hip/hip_runtime.h>
#include <hip/hip_cooperative_groups.h>
#include <cstdio>
#include <cstdint>
#include <cmath>
namespace cg = cooperative_groups;

#ifndef MK_PER_PHASE
#define MK_PER_PHASE 0
#endif

#define LAS __attribute__((address_space(3)))
typedef unsigned short bf16_t;
typedef short bf16x8 __attribute__((ext_vector_type(8)));
typedef short s16x4 __attribute__((ext_vector_type(4)));
typedef float f32x4 __attribute__((ext_vector_type(4)));
typedef unsigned u32x4 __attribute__((ext_vector_type(4)));
typedef unsigned u32x2 __attribute__((ext_vector_type(2)));

constexpr int SEQ = 16384, DM = 2048, DFF = 5632, NHEAD = 16, HDIM = 128;
constexpr int NTHR = 512;
constexpr float RMS_EPS = 1e-6f;

constexpr size_t SZ_W13 = (size_t)2 * DFF * DM * 2;
constexpr size_t SZ_W2 = (size_t)DM * DFF * 2;
constexpr size_t WS_W13 = 0;
constexpr size_t WS_W2 = WS_W13 + 2 * SZ_W13;
constexpr size_t WS_WA = WS_W2 + 2 * SZ_W2;
constexpr size_t WS_WB = WS_WA + (size_t)6144 * DM * 2;
constexpr size_t WS_POOLW = WS_WB + (size_t)DM * DM * 2;
constexpr size_t WS_ROPE = WS_POOLW + (size_t)4 * 256 * 256 * 2;
constexpr size_t WS_XN = WS_ROPE + (size_t)SEQ * 32 * 4;
constexpr size_t WS_BIG = WS_XN + (size_t)SEQ * DM * 2;
constexpr size_t WS_OG = WS_BIG + (size_t)SEQ * 6144 * 2;
constexpr size_t WS_LSE = WS_OG + (size_t)3 * SEQ * DM * 2;
constexpr size_t WS_HB = WS_LSE + (size_t)3 * SEQ * 16 * 4;
constexpr size_t WS_RS = WS_HB + (size_t)SEQ * DM * 2;
constexpr size_t WS_BAR = WS_RS + (size_t)7 * SEQ * 4;
constexpr size_t BAR_BYTES = 3456 * 4;
constexpr size_t WS_END = WS_BAR + 16384;

constexpr int BM = 256, BK = 64, HALF = 128, HTB = HALF * BK * 2, STAGE_BYTES = 8 * HTB, NXCD = 8, WGM = 8;

__host__ __device__ __forceinline__ int lds_byte(int r, int c) { const int st = (r >> 4) * 2 + (c >> 5), rr = r & 15, cc = c & 31, ob = rr * 64 + cc * 2; return st * 1024 + (ob ^ (((ob >> 9) & 1) << 5)); }
__host__ __device__ __forceinline__ void stage_rc(int b, int& R, int& C) { const int st = b / 1024, sb = b % 1024, swz = sb ^ (((sb >> 9) & 1) << 5); R = (st >> 1) * 16 + swz / 64; C = (st & 1) * 32 + (swz % 64) / 2; }
__host__ __device__ __forceinline__ int perm32(int rho) { const int n = rho >> 4, i = rho & 15; return 8 * (i >> 2) + 4 * n + (i & 3); }

struct Unit { int pm, pn; };
struct Gemm { const bf16_t* A; const bf16_t* Bt; int lda, ldb, M, N, K; int a_pn_off; int rev0 = 0; };

struct StaticOrder {
    int nM, nN, nwg, G, c, wgm;
    __device__ void init(int M, int N, int G_, int c_, int wgm_ = WGM) { nM = M / BM; nN = N / BM; nwg = nM * nN; G = G_; c = c_; wgm = wgm_; }
    __device__ bool next(int i, Unit& u) const {
        const long L = (long)i * G + c; if (L >= nwg) return false;
        int wgid = (int)L; { const int q = nwg / NXCD, r = nwg % NXCD, xcd = wgid % NXCD, off = wgid / NXCD; wgid = (xcd < r ? xcd * (q + 1) : r * (q + 1) + (xcd - r) * q) + off; }
        const int nig = wgm * nN, gid = wgid / nig, fm = gid * wgm, gsz = (nM - fm) < wgm ? (nM - fm) : wgm;
        u.pm = fm + ((wgid % nig) % gsz); u.pn = (wgid % nig) / gsz; return true;
    }
};

__device__ __forceinline__ unsigned cvt_pk_bf16(float lo, float hi) { unsigned r; asm volatile("v_cvt_pk_bf16_f32 %0, %1, %2" : "=v"(r) : "v"(lo), "v"(hi)); return r; }
__device__ __forceinline__ float bf_lo(unsigned w) { return __uint_as_float(w << 16); }
__device__ __forceinline__ float bf_hi(unsigned w) { return __uint_as_float(w & 0xffff0000u); }
__device__ __forceinline__ float rs_to_r(float ss) { return __builtin_amdgcn_rsqf(ss * (1.0f / DM) + RMS_EPS); }
__device__ __forceinline__ float silu_f(float v) { return v * __builtin_amdgcn_rcpf(1.0f + __expf(-v)); }


struct EpiSwiglu {
    static constexpr bool PERM = true;
    bf16_t* O; int ldc; const float* rs;
    __device__ __forceinline__ void operator()(const f32x4 (&acc)[2][2][4][2], const Unit& u, int wr, int wc, int fr, int fq) const {
        const int row0 = u.pm * BM + wr * 64 + fr, col0 = u.pn * HALF + wc * 32 + 8 * fq;
        float rr[2][4];
#pragma unroll
        for (int ai = 0; ai < 2; ++ai)
#pragma unroll
            for (int m = 0; m < 4; ++m) rr[ai][m] = rs[row0 + ai * HALF + m * 16];
#pragma unroll
        for (int ai = 0; ai < 2; ++ai)
#pragma unroll
            for (int m = 0; m < 4; ++m) {
                const int row = row0 + ai * HALF + m * 16;
                bf16_t* rowp = O + (size_t)row * ldc + col0;
                const float r = rs_to_r(rr[ai][m]);
                const float nrl = -1.4426950408889634f * r, r2 = r * r;
                const f32x4 g0 = acc[ai][0][m][0], g1 = acc[ai][0][m][1], u0 = acc[ai][1][m][0], u1 = acc[ai][1][m][1];
                const f32x4 t0 = g0 * nrl, t1 = g1 * nrl;
                f32x4 e0, e1;
#pragma unroll
                for (int j = 0; j < 4; ++j) { e0[j] = __builtin_amdgcn_exp2f(t0[j]); e1[j] = __builtin_amdgcn_exp2f(t1[j]); }
                e0 = e0 + 1.0f; e1 = e1 + 1.0f;
#pragma unroll
                for (int j = 0; j < 4; ++j) { e0[j] = __builtin_amdgcn_rcpf(e0[j]); e1[j] = __builtin_amdgcn_rcpf(e1[j]); }
                const f32x4 v0 = (g0 * u0) * r2 * e0, v1 = (g1 * u1) * r2 * e1;
                u32x4 w; w.x = cvt_pk_bf16(v0[0], v0[1]); w.y = cvt_pk_bf16(v0[2], v0[3]); w.z = cvt_pk_bf16(v1[0], v1[1]); w.w = cvt_pk_bf16(v1[2], v1[3]);
                *(u32x4*)rowp = w;
            }
    }
};
struct EpiBf16 {
    static constexpr bool PERM = true;
    bf16_t* O; int ldc; const float* scale; const float* rs;
    __device__ __forceinline__ void operator()(const f32x4 (&acc)[2][2][4][2], const Unit& u, int wr, int wc, int fr, int fq) const {
        const int row0 = u.pm * BM + wr * 64 + fr, col0 = u.pn * BM + wc * 32 + 8 * fq;
        f32x4 sv[2][2];
#pragma unroll
        for (int bj = 0; bj < 2; ++bj)
#pragma unroll
            for (int n = 0; n < 2; ++n) sv[bj][n] = scale ? *(const f32x4*)(scale + col0 + bj * HALF + 4 * n) : (f32x4){1.f, 1.f, 1.f, 1.f};
        float rr[2][4];
#pragma unroll
        for (int ai = 0; ai < 2; ++ai)
#pragma unroll
            for (int m = 0; m < 4; ++m) rr[ai][m] = rs ? rs[row0 + ai * HALF + m * 16] : 0.f;
#pragma unroll
        for (int ai = 0; ai < 2; ++ai)
#pragma unroll
            for (int m = 0; m < 4; ++m) {
                const int row = row0 + ai * HALF + m * 16;
                bf16_t* rowp = O + (size_t)row * ldc + col0;
                const float r = rs ? rs_to_r(rr[ai][m]) : 1.0f;
#pragma unroll
                for (int bj = 0; bj < 2; ++bj) {
                    const f32x4 v0 = acc[ai][bj][m][0] * sv[bj][0] * r, v1 = acc[ai][bj][m][1] * sv[bj][1] * r;
                    u32x4 w; w.x = cvt_pk_bf16(v0[0], v0[1]); w.y = cvt_pk_bf16(v0[2], v0[3]); w.z = cvt_pk_bf16(v1[0], v1[1]); w.w = cvt_pk_bf16(v1[2], v1[3]);
                    *(u32x4*)(rowp + bj * HALF) = w;
                }
            }
    }
};
template <bool HALFA, int SLOT> struct EpiResid {
    static constexpr bool PERM = true;
    float* rsbase;
    __device__ __forceinline__ void operator()(const f32x4 (&acc)[2][2][4][2], const Unit& u, int wr, int wc, int fr, int fq) const {
        const int row0 = u.pm * BM + wr * 64 + fr, col0 = u.pn * BM + wc * 32 + 8 * fq;
        constexpr int ldc = DM; constexpr float alpha = HALFA ? 0.5f : 1.0f;
        float* rs = rsbase + (size_t)SLOT * SEQ;
        bf16_t* hb = (bf16_t*)((unsigned char*)rsbase - (size_t)SEQ * DM * 2);
        float ssv[2][4];
#pragma unroll
        for (int ai = 0; ai < 2; ++ai) {
            u32x4 b[4][2];
#pragma unroll
            for (int m = 0; m < 4; ++m)
#pragma unroll
                for (int bj = 0; bj < 2; ++bj) b[m][bj] = *(const u32x4*)(hb + (size_t)(row0 + ai * HALF + m * 16) * ldc + col0 + bj * HALF);
            __builtin_amdgcn_sched_barrier(0);
#pragma unroll
            for (int m = 0; m < 4; ++m) {
                const size_t off = (size_t)(row0 + ai * HALF + m * 16) * ldc + col0;
                float ss = 0.f;
#pragma unroll
                for (int bj = 0; bj < 2; ++bj) {
                    const f32x4 b0 = (f32x4){bf_lo(b[m][bj].x), bf_hi(b[m][bj].x), bf_lo(b[m][bj].y), bf_hi(b[m][bj].y)};
                    const f32x4 b1 = (f32x4){bf_lo(b[m][bj].z), bf_hi(b[m][bj].z), bf_lo(b[m][bj].w), bf_hi(b[m][bj].w)};
                    const f32x4 v0 = b0 + alpha * acc[ai][bj][m][0], v1 = b1 + alpha * acc[ai][bj][m][1];
                    ss += (v0[0] * v0[0] + v0[1] * v0[1]) + (v0[2] * v0[2] + v0[3] * v0[3]) + (v1[0] * v1[0] + v1[1] * v1[1]) + (v1[2] * v1[2] + v1[3] * v1[3]);
                    u32x4 w; w.x = cvt_pk_bf16(v0[0], v0[1]); w.y = cvt_pk_bf16(v0[2], v0[3]); w.z = cvt_pk_bf16(v1[0], v1[1]); w.w = cvt_pk_bf16(v1[2], v1[3]);
                    *(u32x4*)(hb + off + bj * HALF) = w;
                }
                ssv[ai][m] = ss;
            }
            __builtin_amdgcn_sched_barrier(0);
        }
#pragma unroll
        for (int ai = 0; ai < 2; ++ai)
#pragma unroll
            for (int m = 0; m < 4; ++m) {
                float ss = ssv[ai][m];
                ss += __shfl_xor(ss, 16); ss += __shfl_xor(ss, 32);
                if (fq == 0) (void)__hip_atomic_fetch_add(rs + row0 + ai * HALF + m * 16, ss, __ATOMIC_RELAXED, __HIP_MEMORY_SCOPE_AGENT);
            }
    }
};
struct EpiQkv {
    static constexpr bool PERM = true;
    bf16_t* O; int ldc; const float* rope; const float* rs;
    __device__ __forceinline__ void operator()(const f32x4 (&acc)[2][2][4][2], const Unit& u, int wr, int wc, int fr, int fq) const {
        const int row0 = u.pm * BM + wr * 64 + fr, col0 = u.pn * BM + wc * 32 + 8 * fq;
        const bool rot = (wc == 0) && (u.pn < 16);
        float rr[2][4];
#pragma unroll
        for (int ai = 0; ai < 2; ++ai)
#pragma unroll
            for (int m = 0; m < 4; ++m) rr[ai][m] = rs[row0 + ai * HALF + m * 16];
        f32x4 csa[2][4], sna[2][4];
#pragma unroll
        for (int ai = 0; ai < 2; ++ai)
#pragma unroll
            for (int m = 0; m < 4; ++m) {
                const int row = row0 + ai * HALF + m * 16;
                csa[ai][m] = (f32x4){1.f, 1.f, 1.f, 1.f}; sna[ai][m] = (f32x4){0.f, 0.f, 0.f, 0.f};
                if (rot) { csa[ai][m] = *(const f32x4*)(rope + (size_t)row * 32 + 4 * fq); sna[ai][m] = *(const f32x4*)(rope + (size_t)row * 32 + 16 + 4 * fq); }
            }
        __builtin_amdgcn_sched_barrier(0);
#pragma unroll
        for (int ai = 0; ai < 2; ++ai) {
#pragma unroll
            for (int m = 0; m < 4; ++m) {
                const int row = row0 + ai * HALF + m * 16;
                bf16_t* rowp = O + (size_t)row * ldc + col0;
                const float r = rs_to_r(rr[ai][m]);
                const f32x4 cs = csa[ai][m], sn = sna[ai][m];
#pragma unroll
                for (int bj = 0; bj < 2; ++bj) {
                    const f32x4 x1 = acc[ai][bj][m][0] * r, x2 = acc[ai][bj][m][1] * r;
                    const f32x4 r1 = x1 * cs - x2 * sn, r2 = x2 * cs + x1 * sn;
                    u32x4 w; w.x = cvt_pk_bf16(r1[0], r1[1]); w.y = cvt_pk_bf16(r1[2], r1[3]); w.z = cvt_pk_bf16(r2[0], r2[1]); w.w = cvt_pk_bf16(r2[2], r2[3]);
                    *(u32x4*)(rowp + bj * HALF) = w;
                }
            }
            __builtin_amdgcn_sched_barrier(0);
        }
    }
};

template <class Epi>
__device__ __forceinline__ void gemm_phase(LAS unsigned char* lds, const Gemm g, const StaticOrder S, const Epi E) {
    const int tid = threadIdx.x, wid = __builtin_amdgcn_readfirstlane(tid >> 6), lane = tid & 63, wr = wid >> 2, wc = wid & 3, fr = lane & 15, fq = lane >> 4;
    const int K = g.K, nt = K / BK;
    unsigned voffA[2], voffB[2];
#pragma unroll
    for (int i = 0; i < 2; ++i) { int R, C; stage_rc(tid * 16 + i * 8192, R, C); const int Rb = Epi::PERM ? ((R & ~31) + perm32(R & 31)) : R;
        voffA[i] = (unsigned)(R * g.lda + C) * 2u; voffB[i] = (unsigned)(Rb * g.ldb + C) * 2u; }
    const size_t kstep = (size_t)(BK * 2);
    const size_t hstepA = (size_t)HALF * g.lda * 2, hstepB = (size_t)HALF * g.ldb * 2;
    const size_t tstepA = 2 * hstepA, tstepB = 2 * hstepB;
    const unsigned ldsw = (unsigned)wid * 1024u;
    const int aoff = lds_byte(wr * 64 + fr, fq * 8), boff = lds_byte(wc * 32 + fr, fq * 8);
#define PG8_SA(b, h) (((b) * 2 + (h)) * HTB)
#define PG8_SB(b, h) ((4 + (b) * 2 + (h)) * HTB)
#define PG8_STAGE(bufoff, gbase, voff) do { _Pragma("unroll") for (int _i = 0; _i < 2; ++_i) \
        __builtin_amdgcn_global_load_lds((const unsigned*)((const char*)(gbase) + (voff)[_i]), (LAS unsigned*)(lds + (bufoff) + ldsw + _i * 8192), 16, 0, 0); } while (0)
#define PG8_LDA(dst, b, h) do { _Pragma("unroll") for (int m = 0; m < 4; ++m) _Pragma("unroll") for (int k = 0; k < 2; ++k) dst[m][k] = *(const LAS bf16x8*)(lds + PG8_SA(b, h) + aoff + m * 2048 + k * 1024); } while (0)
#define PG8_LDB(dst, b, h) do { _Pragma("unroll") for (int n = 0; n < 2; ++n) _Pragma("unroll") for (int k = 0; k < 2; ++k) dst[n][k] = *(const LAS bf16x8*)(lds + PG8_SB(b, h) + boff + n * 2048 + k * 1024); } while (0)
#define PG8_MMA(ai, bj, At, Bt) do { __builtin_amdgcn_s_setprio(1); _Pragma("unroll") for (int m = 0; m < 4; ++m) _Pragma("unroll") for (int n = 0; n < 2; ++n) _Pragma("unroll") for (int k = 0; k < 2; ++k) \
        acc[ai][bj][m][n] = __builtin_amdgcn_mfma_f32_16x16x32_bf16(Bt[n][k], At[m][k], acc[ai][bj][m][n], 0, 0, 0); __builtin_amdgcn_s_setprio(0); } while (0)
#define PG8_WAIT_V(n) asm volatile("s_waitcnt vmcnt(" #n ")" ::: "memory")
#define PG8_WAIT_L(n) asm volatile("s_waitcnt lgkmcnt(" #n ")" ::: "memory")
#define PG8_BAR __builtin_amdgcn_s_barrier()
#define PG8_SCHED __builtin_amdgcn_sched_barrier(0)
    Unit cur, nxt; int ui = 0;
    if (!S.next(0, cur)) return;
    f32x4 acc[2][2][4][2];
#pragma unroll
    for (int a = 0; a < 2; ++a)
#pragma unroll
        for (int b = 0; b < 2; ++b)
#pragma unroll
            for (int m = 0; m < 4; ++m)
#pragma unroll
                for (int n = 0; n < 2; ++n) acc[a][b][m][n] = (f32x4){0.f, 0.f, 0.f, 0.f};
    bf16x8 At[4][2], B0[2][2], B1[2][2];
    const long klast = (long)(nt - 1) * (long)kstep;
    long ksc = g.rev0 ? -(long)kstep : (long)kstep, ksn = ksc;
    const char* cA = (const char*)g.A + (size_t)cur.pm * tstepA + (size_t)cur.pn * g.a_pn_off + (g.rev0 ? klast : 0); const char* cB = (const char*)g.Bt + (size_t)cur.pn * tstepB + (g.rev0 ? klast : 0);
    PG8_STAGE(PG8_SB(0, 0), cB, voffB); PG8_STAGE(PG8_SB(0, 1), cB + hstepB, voffB); PG8_STAGE(PG8_SA(0, 0), cA, voffA); PG8_STAGE(PG8_SA(0, 1), cA + hstepA, voffA);
    if (wr == 1) PG8_BAR;
    PG8_WAIT_V(2); PG8_BAR;
    PG8_STAGE(PG8_SB(1, 0), cB + ksc, voffB); PG8_STAGE(PG8_SA(1, 0), cA + ksc, voffA); PG8_STAGE(PG8_SB(1, 1), cB + hstepB + ksc, voffB);
    PG8_WAIT_V(6); PG8_BAR;
    for (;;) {
        const bool has_next = S.next(ui + 1, nxt);
        const bool nrev = has_next && ((ui + 1 + g.rev0) & 1);
        ksn = has_next ? (nrev ? -(long)kstep : (long)kstep) : ksc;
        const char* nA = has_next ? (const char*)g.A + (size_t)nxt.pm * tstepA + (size_t)nxt.pn * g.a_pn_off + (nrev ? klast : 0) : cA;
        const char* nB = has_next ? (const char*)g.Bt + (size_t)nxt.pn * tstepB + (nrev ? klast : 0) : cB;
        for (int t = 0; t < nt; t += 2) {
            const bool last = (t == nt - 2);
            const char* a1 = cA + (long)(t + 1) * ksc;
            const char* a2 = last ? nA : cA + (long)(t + 2) * ksc; const char* b2 = last ? nB : cB + (long)(t + 2) * ksc;
            const long ks3 = last ? ksn : ksc;
            const char* a3 = a2 + ks3; const char* b3 = b2 + ks3;
            PG8_LDB(B0, 0, 0); PG8_LDB(B1, 0, 1); PG8_SCHED; PG8_LDA(At, 0, 0); PG8_STAGE(PG8_SA(1, 1), a1 + hstepA, voffA);
            PG8_WAIT_V(8); PG8_WAIT_L(0); PG8_BAR; PG8_MMA(0, 0, At, B0); PG8_MMA(0, 1, At, B1); PG8_BAR; PG8_SCHED;
            PG8_LDA(At, 0, 1); PG8_STAGE(PG8_SB(0, 0), b2, voffB); PG8_STAGE(PG8_SB(0, 1), b2 + hstepB, voffB); PG8_STAGE(PG8_SA(0, 0), a2, voffA);
            PG8_WAIT_V(8); PG8_WAIT_L(0); PG8_BAR; PG8_MMA(1, 0, At, B0); PG8_MMA(1, 1, At, B1); PG8_BAR; PG8_SCHED;
            PG8_LDB(B0, 1, 0); PG8_LDB(B1, 1, 1); PG8_SCHED; PG8_LDA(At, 1, 0); PG8_STAGE(PG8_SA(0, 1), a2 + hstepA, voffA);
            PG8_WAIT_V(8); PG8_WAIT_L(0); PG8_BAR; PG8_MMA(0, 0, At, B0); PG8_MMA(0, 1, At, B1); PG8_BAR; PG8_SCHED;
            PG8_LDA(At, 1, 1); PG8_STAGE(PG8_SB(1, 0), b3, voffB); PG8_STAGE(PG8_SB(1, 1), b3 + hstepB, voffB); PG8_STAGE(PG8_SA(1, 0), a3, voffA);
            PG8_WAIT_V(8); PG8_WAIT_L(0); PG8_BAR; PG8_MMA(1, 0, At, B0); PG8_MMA(1, 1, At, B1); PG8_BAR; PG8_SCHED;
        }
        if (wr == 0) PG8_BAR;
        E(acc, cur, wr, wc, fr, fq);
        if (!has_next) break;
#pragma unroll
        for (int a = 0; a < 2; ++a)
#pragma unroll
            for (int b = 0; b < 2; ++b)
#pragma unroll
                for (int m = 0; m < 4; ++m)
#pragma unroll
                    for (int n = 0; n < 2; ++n) acc[a][b][m][n] = (f32x4){0.f, 0.f, 0.f, 0.f};
        cur = nxt; cA = nA; cB = nB; ksc = ksn; ++ui;
        if (wr == 1) PG8_BAR;
    }
    PG8_WAIT_V(0);
    PG8_BAR;
#undef PG8_SA
#undef PG8_SB
#undef PG8_STAGE
#undef PG8_LDA
#undef PG8_LDB
#undef PG8_MMA
#undef PG8_WAIT_V
#undef PG8_WAIT_L
#undef PG8_BAR
#undef PG8_SCHED
}

__device__ __forceinline__ void convert_w(LAS float* tile, const float* __restrict__ src, int K, int N, bf16_t* __restrict__ dst, int mode, int sidx, const float* __restrict__ gk, int G, int bid) {
    const int tid = threadIdx.x;
    const int tk = K / 64, tn = N / 64, ntile = tk * tn;
    const int kk = tid >> 4, n4 = (tid & 15) * 4;
    f32x4 pv[2];
    if (bid < ntile) {
        const int k0 = (bid % tk) * 64, n0 = (bid / tk) * 64;
#pragma unroll
        for (int i = 0; i < 2; ++i) pv[i] = __builtin_nontemporal_load((const f32x4*)(src + (size_t)(k0 + kk + 32 * i) * N + n0 + n4));
    }
    for (int t = bid; t < ntile; t += G) {
        const int k0 = (t % tk) * 64, n0 = (t / tk) * 64;
#pragma unroll
        for (int i = 0; i < 2; ++i) {
            const int k = kk + 32 * i;
            tile[k * 65 + n4 + 0] = pv[i][0]; tile[k * 65 + n4 + 1] = pv[i][1]; tile[k * 65 + n4 + 2] = pv[i][2]; tile[k * 65 + n4 + 3] = pv[i][3];
        }
        __syncthreads();
        if (t + G < ntile) {
            const int k1 = ((t + G) % tk) * 64, n1 = ((t + G) / tk) * 64;
#pragma unroll
            for (int i = 0; i < 2; ++i) pv[i] = __builtin_nontemporal_load((const f32x4*)(src + (size_t)(k1 + kk + 32 * i) * N + n1 + n4));
        }
        const int n = tid >> 3, k8 = (tid & 7) * 8;
        float f[8];
#pragma unroll
        for (int j = 0; j < 8; ++j) f[j] = tile[(k8 + j) * 65 + n];
        if (gk) {
            const f32x4 ga = *(const f32x4*)(gk + k0 + k8), gb = *(const f32x4*)(gk + k0 + k8 + 4);
            f[0] *= ga[0]; f[1] *= ga[1]; f[2] *= ga[2]; f[3] *= ga[3]; f[4] *= gb[0]; f[5] *= gb[1]; f[6] *= gb[2]; f[7] *= gb[3];
        }
        u32x4 w; w.x = cvt_pk_bf16(f[0], f[1]); w.y = cvt_pk_bf16(f[2], f[3]); w.z = cvt_pk_bf16(f[4], f[5]); w.w = cvt_pk_bf16(f[6], f[7]);
        const int nn = n0 + n;
        int row = nn;
        if (mode == 1) row = 256 * (nn >> 7) + 128 * sidx + (nn & 127);
        if (mode == 2 && nn < 4096 && (nn & 127) < 32) { const int d = nn & 31; row = (nn & ~31) + 8 * ((d >> 2) & 3) + 4 * (d >> 4) + (d & 3); }
        *(u32x4*)(dst + (size_t)row * K + k0 + k8) = w;
        __syncthreads();
    }
}

__device__ __forceinline__ float wave_sum(float v) {
#pragma unroll
    for (int o = 32; o >= 1; o >>= 1) v += __shfl_xor(v, o);
    return v;
}

__device__ __forceinline__ void cast_phase(const float* src, bf16_t* hb, float* rs, int G, int bid) {
    const int wave = threadIdx.x >> 6, lane = threadIdx.x & 63;
    for (int i = bid * NTHR + threadIdx.x; i < 6 * SEQ; i += G * NTHR) rs[SEQ + i] = 0.f;
    for (int row = bid * 8 + wave; row < SEQ; row += G * 8) {
        const float* p = src + (size_t)row * DM + lane * 8;
        f32x4 v[8];
#pragma unroll
        for (int i = 0; i < 4; ++i) { v[2 * i] = __builtin_nontemporal_load((const f32x4*)(p + i * 512)); v[2 * i + 1] = __builtin_nontemporal_load((const f32x4*)(p + i * 512 + 4)); }
        float ss = 0.f;
#pragma unroll
        for (int i = 0; i < 8; ++i) ss += v[i][0] * v[i][0] + v[i][1] * v[i][1] + v[i][2] * v[i][2] + v[i][3] * v[i][3];
        ss = wave_sum(ss);
        if (lane == 0) rs[row] = ss;
#pragma unroll
        for (int i = 0; i < 4; ++i) {
            const f32x4 a = v[2 * i], b = v[2 * i + 1];
            u32x4 w; w.x = cvt_pk_bf16(a[0], a[1]); w.y = cvt_pk_bf16(a[2], a[3]); w.z = cvt_pk_bf16(b[0], b[1]); w.w = cvt_pk_bf16(b[2], b[3]);
            *(u32x4*)(hb + (size_t)row * DM + i * 512 + lane * 8) = w;
        }
    }
}
__device__ __forceinline__ void final_norm_phase(const bf16_t* __restrict__ hb, const float* __restrict__ g, const float* __restrict__ rs, float* __restrict__ dst, int G, int bid) {
    const int wave = threadIdx.x >> 6, lane = threadIdx.x & 63;
    for (int row = bid * 8 + wave; row < SEQ; row += G * 8) {
        const bf16_t* p = hb + (size_t)row * DM + lane * 8;
        u32x4 v[4];
#pragma unroll
        for (int i = 0; i < 4; ++i) v[i] = *(const u32x4*)(p + i * 512);
        const float r = rs_to_r(rs[row]);
        float* q = dst + (size_t)row * DM + lane * 8;
#pragma unroll
        for (int i = 0; i < 4; ++i) {
            const f32x4 g0 = *(const f32x4*)(g + i * 512 + lane * 8), g1 = *(const f32x4*)(g + i * 512 + lane * 8 + 4);
            const f32x4 a = (f32x4){bf_lo(v[i].x), bf_hi(v[i].x), bf_lo(v[i].y), bf_hi(v[i].y)}, b = (f32x4){bf_lo(v[i].z), bf_hi(v[i].z), bf_lo(v[i].w), bf_hi(v[i].w)};
            *(f32x4*)(q + i * 512) = a * r * g0; *(f32x4*)(q + i * 512 + 4) = b * r * g1;
        }
    }
}

struct InvFreq { float v[16]; };
__device__ __forceinline__ void rope_phase(const int* pos, const InvFreq& inv, float* rope, int G, int bid) {
    for (int idx = bid * NTHR + threadIdx.x; idx < SEQ * 16; idx += G * NTHR) {
        const int t = idx >> 4, i = idx & 15;
        float fv = inv.v[0];
#pragma unroll
        for (int j = 1; j < 16; ++j) fv = (i == j) ? inv.v[j] : fv;
        const float ang = (float)pos[t] * fv;
        const double rev = (double)ang * 0.15915494309189533577;
        const float fr = (float)(rev - rint(rev));
        rope[(size_t)t * 32 + i] = __builtin_amdgcn_cosf(fr);
        rope[(size_t)t * 32 + 16 + i] = __builtin_amdgcn_sinf(fr);
    }
}

__device__ __forceinline__ void convpool_phase(const bf16_t* __restrict__ z, const float* __restrict__ conv_w, bf16_t* __restrict__ ycat, bf16_t* __restrict__ pooled, int G, int bid) {
#pragma unroll 2
    for (int idx = bid * NTHR + threadIdx.x; idx < SEQ * 128; idx += G * NTHR) {
        const int t = idx >> 7, c0 = (idx & 127) * 8;
        u32x4 gc[3], hv[3];
#pragma unroll
        for (int j = 0; j < 3; ++j) {
            const int tt = t - 2 + j, tc = tt < 0 ? 0 : tt;
            gc[j] = *(const u32x4*)(z + (size_t)tc * 4096 + 1024 + c0); hv[j] = *(const u32x4*)(z + (size_t)tc * 4096 + 2048 + c0);
        }
        const u32x4 gb = *(const u32x4*)(z + (size_t)t * 4096 + c0);
        float a[8];
#pragma unroll
        for (int e = 0; e < 8; ++e) a[e] = 0.f;
#pragma unroll
        for (int j = 0; j < 3; ++j) {
            const float wm = (t - 2 + j) >= 0 ? 1.f : 0.f;
            const f32x4 w0 = *(const f32x4*)(conv_w + j * 1024 + c0) * wm, w1 = *(const f32x4*)(conv_w + j * 1024 + c0 + 4) * wm;
            a[0] += w0[0] * (bf_lo(gc[j].x) * bf_lo(hv[j].x)); a[1] += w0[1] * (bf_hi(gc[j].x) * bf_hi(hv[j].x));
            a[2] += w0[2] * (bf_lo(gc[j].y) * bf_lo(hv[j].y)); a[3] += w0[3] * (bf_hi(gc[j].y) * bf_hi(hv[j].y));
            a[4] += w1[0] * (bf_lo(gc[j].z) * bf_lo(hv[j].z)); a[5] += w1[1] * (bf_hi(gc[j].z) * bf_hi(hv[j].z));
            a[6] += w1[2] * (bf_lo(gc[j].w) * bf_lo(hv[j].w)); a[7] += w1[3] * (bf_hi(gc[j].w) * bf_hi(hv[j].w));
        }
        u32x4 w;
        w.x = cvt_pk_bf16(bf_lo(gb.x) * a[0], bf_hi(gb.x) * a[1]); w.y = cvt_pk_bf16(bf_lo(gb.y) * a[2], bf_hi(gb.y) * a[3]);
        w.z = cvt_pk_bf16(bf_lo(gb.z) * a[4], bf_hi(gb.z) * a[5]); w.w = cvt_pk_bf16(bf_lo(gb.w) * a[6], bf_hi(gb.w) * a[7]);
        *(u32x4*)(ycat + (size_t)t * DM + c0) = w;
    }
    for (int idx = bid * NTHR + threadIdx.x; idx < (SEQ / 4) * 128; idx += G * NTHR) {
        const int t0 = (idx >> 7) * 4, c0 = (idx & 127) * 8, win = 2 << (c0 >> 8);
        u32x4 uv[19];
#pragma unroll
        for (int i = 0; i < 19; ++i) { const int row = t0 - 15 + i, rc = row < 0 ? 0 : row; uv[i] = *(const u32x4*)(z + (size_t)rc * 4096 + 3072 + c0); }
        float a[4][8];
#pragma unroll
        for (int k = 0; k < 4; ++k)
#pragma unroll
            for (int e = 0; e < 8; ++e) a[k][e] = 0.f;
#pragma unroll
        for (int i = 0; i < 19; ++i) {
            const int d = i - 15;
            const float x0 = bf_lo(uv[i].x), x1 = bf_hi(uv[i].x), x2 = bf_lo(uv[i].y), x3 = bf_hi(uv[i].y), x4 = bf_lo(uv[i].z), x5 = bf_hi(uv[i].z), x6 = bf_lo(uv[i].w), x7 = bf_hi(uv[i].w);
#pragma unroll
            for (int k = 0; k < 4; ++k) {
                if (d <= k) {
                    const float mk = (d >= k - win + 1 && t0 + d >= 0) ? 1.f : 0.f;
                    a[k][0] += mk * x0; a[k][1] += mk * x1; a[k][2] += mk * x2; a[k][3] += mk * x3; a[k][4] += mk * x4; a[k][5] += mk * x5; a[k][6] += mk * x6; a[k][7] += mk * x7;
                }
            }
        }
#pragma unroll
        for (int k = 0; k < 4; ++k) {
            const int t = t0 + k, n = (t + 1) < win ? (t + 1) : win;
            const float rn = 1.0f / (float)n;
            const u32x4 u0 = uv[15 + k];
            u32x4 w;
            w.x = cvt_pk_bf16(a[k][0] * rn - bf_lo(u0.x), a[k][1] * rn - bf_hi(u0.x)); w.y = cvt_pk_bf16(a[k][2] * rn - bf_lo(u0.y), a[k][3] * rn - bf_hi(u0.y));
            w.z = cvt_pk_bf16(a[k][4] * rn - bf_lo(u0.z), a[k][5] * rn - bf_hi(u0.z)); w.w = cvt_pk_bf16(a[k][6] * rn - bf_lo(u0.w), a[k][7] * rn - bf_hi(u0.w));
            *(u32x4*)(pooled + (size_t)t * 1024 + c0) = w;
        }
    }
}

constexpr int KP = 272;
constexpr int ATT_LDS = 2 * 256 * KP;
__device__ __forceinline__ void attn_phase(LAS unsigned char* lds, const bf16_t* qkv, bf16_t* og, float* lse, int G, int bid) {
    const int tid = threadIdx.x, wid = __builtin_amdgcn_readfirstlane(tid >> 6), lane = tid & 63, fr = lane & 15, fq = lane >> 4;
    LAS unsigned char* Ks = lds; LAS unsigned char* Vs = lds + 256 * KP;
    const float sl2 = 0.08838834764831845f * 1.4426950408889634f;
    const int srow = tid >> 4, sch = tid & 15;
    constexpr int NSEG = 3 * 16 * 16, SEGLEN = 8;
    for (int seg = bid; seg < NSEG; seg += G) {
        const int h8 = seg & 7, tq = seg >> 3, sidx = tq & 15, uq = tq >> 4, gb = uq % 3, h = (uq / 3) * 8 + h8;
        const int sh = 2 * gb, dil = 1 << sh, r = sidx & (dil - 1), blk0 = (sidx >> sh) * SEGLEN;
        const bf16_t* kbase = qkv + 2048 + h * 128 + sch * 8;
        u32x4 rk[4], rv[4]; bf16x8 rq[4];
        __syncthreads();
        if (blk0 > 0) {
#pragma unroll
            for (int i = 0; i < 4; ++i) { const int c = srow + 32 * i; const size_t pos = (size_t)(((blk0 - 1) * 128 + c) * dil + r);
                rk[i] = *(const u32x4*)(kbase + pos * 6144); rv[i] = *(const u32x4*)(kbase + pos * 6144 + 2048); }
#pragma unroll
            for (int i = 0; i < 4; ++i) { const int c = srow + 32 * i; *(LAS u32x4*)(Ks + (128 + c) * KP + sch * 16) = rk[i]; *(LAS u32x4*)(Vs + (128 + c) * KP + sch * 16) = rv[i]; }
        }
#pragma unroll
        for (int i = 0; i < 4; ++i) { const int c = srow + 32 * i; const size_t pos = (size_t)((blk0 * 128 + c) * dil + r);
            rk[i] = *(const u32x4*)(kbase + pos * 6144); rv[i] = *(const u32x4*)(kbase + pos * 6144 + 2048); }
#pragma unroll
        for (int i = 0; i < 4; ++i) { const int c = srow + 32 * i; *(LAS u32x4*)(Ks + c * KP + sch * 16) = rk[i]; *(LAS u32x4*)(Vs + c * KP + sch * 16) = rv[i]; }
        {
            const size_t posq0 = (size_t)((blk0 * 128 + wid * 16 + fr) * dil + r);
#pragma unroll
            for (int kk = 0; kk < 4; ++kk) rq[kk] = *(const bf16x8*)(qkv + posq0 * 6144 + h * 128 + kk * 32 + fq * 8);
        }
        for (int j = 0; j < SEGLEN; ++j) {
            const int blk = blk0 + j, cs = j & 1, ps = cs ^ 1;
            bf16x8 Q[4];
#pragma unroll
            for (int kk = 0; kk < 4; ++kk) Q[kk] = rq[kk];
            __syncthreads();
            if (j + 1 < SEGLEN) {
#pragma unroll
                for (int i = 0; i < 4; ++i) { const int c = srow + 32 * i; const size_t pos = (size_t)(((blk + 1) * 128 + c) * dil + r);
                    rk[i] = *(const u32x4*)(kbase + pos * 6144); rv[i] = *(const u32x4*)(kbase + pos * 6144 + 2048); }
                const size_t posqn = (size_t)(((blk + 1) * 128 + wid * 16 + fr) * dil + r);
#pragma unroll
                for (int kk = 0; kk < 4; ++kk) rq[kk] = *(const bf16x8*)(qkv + posqn * 6144 + h * 128 + kk * 32 + fq * 8);
            }
            const int a = wid * 16 + fr;
            const size_t posq = (size_t)((blk * 128 + a) * dil + r);
            LAS unsigned char* Kp = Ks + ps * 128 * KP; LAS unsigned char* Kc = Ks + cs * 128 * KP;
            LAS unsigned char* Vp = Vs + ps * 128 * KP; LAS unsigned char* Vc = Vs + cs * 128 * KP;
            f32x4 sc[16];
#pragma unroll
            for (int s = 0; s < 16; ++s) {
                sc[s] = (f32x4){0.f, 0.f, 0.f, 0.f};
                if (s >= wid && s <= wid + 8 && (s >= 8 || blk > 0)) {
                    LAS unsigned char* kb = (s < 8 ? Kp : Kc) + (16 * (s & 7) + fr) * KP + 16 * fq;
#pragma unroll
                    for (int kk = 0; kk < 4; ++kk) {
                        const bf16x8 kf = *(const LAS bf16x8*)(kb + 64 * kk);
                        sc[s] = __builtin_amdgcn_mfma_f32_16x16x32_bf16(kf, Q[kk], sc[s], 0, 0, 0);
                    }
                }
            }
            float mx = -3.0e38f;
#pragma unroll
            for (int s = 0; s < 16; ++s) {
                if (s >= wid && s <= wid + 8 && (s >= 8 || blk > 0)) {
#pragma unroll
                    for (int jj = 0; jj < 4; ++jj) {
                        const int c = 16 * s + 4 * fq + jj;
                        const bool valid = (s < 8) ? (c >= a) : (c - 128 <= a);
                        const float v = valid ? sc[s][jj] * sl2 : -1.0e30f;
                        sc[s][jj] = v; mx = fmaxf(mx, v);
                    }
                }
            }
            mx = fmaxf(mx, __shfl_xor(mx, 16)); mx = fmaxf(mx, __shfl_xor(mx, 32));
            float l = 0.f;
#pragma unroll
            for (int s = 0; s < 16; ++s) {
                if (s >= wid && s <= wid + 8 && (s >= 8 || blk > 0)) {
#pragma unroll
                    for (int jj = 0; jj < 4; ++jj) { const float pp = __builtin_amdgcn_exp2f(sc[s][jj] - mx); sc[s][jj] = pp; l += pp; }
                } else sc[s] = (f32x4){0.f, 0.f, 0.f, 0.f};
            }
            l += __shfl_xor(l, 16); l += __shfl_xor(l, 32);
            f32x4 o[8];
#pragma unroll
            for (int dt = 0; dt < 8; ++dt) o[dt] = (f32x4){0.f, 0.f, 0.f, 0.f};
#pragma unroll
            for (int ks = 0; ks < 8; ++ks) {
                if (2 * ks + 1 >= wid && 2 * ks <= wid + 8 && (ks >= 4 || blk > 0)) {
                    union { u32x4 u; bf16x8 b; } P;
                    P.u.x = cvt_pk_bf16(sc[2 * ks][0], sc[2 * ks][1]); P.u.y = cvt_pk_bf16(sc[2 * ks][2], sc[2 * ks][3]);
                    P.u.z = cvt_pk_bf16(sc[2 * ks + 1][0], sc[2 * ks + 1][1]); P.u.w = cvt_pk_bf16(sc[2 * ks + 1][2], sc[2 * ks + 1][3]);
                    LAS unsigned char* vb = (ks < 4 ? Vp : Vc) + (32 * (ks & 3) + 4 * fq + (fr >> 2)) * KP + 8 * (fr & 3);
#pragma unroll
                    for (int dt = 0; dt < 8; ++dt) {
                        const s16x4 v0 = __builtin_amdgcn_ds_read_tr16_b64_v4i16((LAS s16x4*)(vb + 32 * dt));
                        const s16x4 v1 = __builtin_amdgcn_ds_read_tr16_b64_v4i16((LAS s16x4*)(vb + 16 * KP + 32 * dt));
                        const bf16x8 vf = __builtin_shufflevector(v0, v1, 0, 1, 2, 3, 4, 5, 6, 7);
                        o[dt] = __builtin_amdgcn_mfma_f32_16x16x32_bf16(vf, P.b, o[dt], 0, 0, 0);
                    }
                }
            }
            const float inv = 1.0f / l;
            bf16_t* op = og + (size_t)gb * SEQ * DM + posq * DM + h * 128 + ((fq & 1) ? 16 + 4 * (fq - 1) : 4 * fq);
#pragma unroll
            for (int dt = 0; dt < 8; dt += 2) {
                const unsigned ax = cvt_pk_bf16(o[dt][0] * inv, o[dt][1] * inv), ay = cvt_pk_bf16(o[dt][2] * inv, o[dt][3] * inv);
                const unsigned bx = cvt_pk_bf16(o[dt + 1][0] * inv, o[dt + 1][1] * inv), by = cvt_pk_bf16(o[dt + 1][2] * inv, o[dt + 1][3] * inv);
                const auto sx = __builtin_amdgcn_permlane16_swap(ax, bx, false, false);
                const auto sy = __builtin_amdgcn_permlane16_swap(ay, by, false, false);
                u32x4 w; w.x = sx[0]; w.y = sy[0]; w.z = sx[1]; w.w = sy[1];
                *(u32x4*)(op + 16 * dt) = w;
            }
            if (fq == 0) lse[(size_t)gb * SEQ * 16 + posq * 16 + h] = mx * 0.6931471805599453f + __logf(l);
            if (j + 1 < SEGLEN) {
                __syncthreads();
#pragma unroll
                for (int i = 0; i < 4; ++i) { const int c = srow + 32 * i; *(LAS u32x4*)(Ks + (ps * 128 + c) * KP + sch * 16) = rk[i]; *(LAS u32x4*)(Vs + (ps * 128 + c) * KP + sch * 16) = rv[i]; }
            }
        }
    }
}

__device__ __forceinline__ void combine_phase(const bf16_t* __restrict__ og, const float* __restrict__ lse, bf16_t* __restrict__ dst, int G, int bid) {
#pragma unroll 4
    for (int idx = bid * NTHR + threadIdx.x; idx < SEQ * 256; idx += G * NTHR) {
        const int t = idx >> 8, oc = idx & 255, h = oc >> 4;
        const float l0 = lse[(size_t)t * 16 + h], l1 = lse[(size_t)SEQ * 16 + (size_t)t * 16 + h], l2 = lse[(size_t)2 * SEQ * 16 + (size_t)t * 16 + h];
        const float mx = fmaxf(l0, fmaxf(l1, l2));
        float w0 = __expf(l0 - mx), w1 = __expf(l1 - mx), w2 = __expf(l2 - mx);
        const float inv = 1.0f / (w0 + w1 + w2); w0 *= inv; w1 *= inv; w2 *= inv;
        const size_t off = (size_t)t * DM + oc * 8;
        const u32x4 a = *(const u32x4*)(og + off), b = *(const u32x4*)(og + (size_t)SEQ * DM + off), c = *(const u32x4*)(og + (size_t)2 * SEQ * DM + off);
        u32x4 w;
        w.x = cvt_pk_bf16(w0 * bf_lo(a.x) + w1 * bf_lo(b.x) + w2 * bf_lo(c.x), w0 * bf_hi(a.x) + w1 * bf_hi(b.x) + w2 * bf_hi(c.x));
        w.y = cvt_pk_bf16(w0 * bf_lo(a.y) + w1 * bf_lo(b.y) + w2 * bf_lo(c.y), w0 * bf_hi(a.y) + w1 * bf_hi(b.y) + w2 * bf_hi(c.y));
        w.z = cvt_pk_bf16(w0 * bf_lo(a.z) + w1 * bf_lo(b.z) + w2 * bf_lo(c.z), w0 * bf_hi(a.z) + w1 * bf_hi(b.z) + w2 * bf_hi(c.z));
        w.w = cvt_pk_bf16(w0 * bf_lo(a.w) + w1 * bf_lo(b.w) + w2 * bf_lo(c.w), w0 * bf_hi(a.w) + w1 * bf_hi(b.w) + w2 * bf_hi(c.w));
        *(u32x4*)(dst + off) = w;
    }
}


#define XB_TMO      128
#define XB_XCNT(j)  (256  + 64 * (j))
#define XB_XSUB(j)  (1280 + 64 * (j))
#define XB_XGEN(j)  (2304 + 64 * (j))
#define XB_TOP      3328
#define XB_TOPGEN   3392
#define XCD_BAR_WORDS 3456
#define XB_SPIN_CAP (1u << 22)
__device__ __forceinline__ unsigned xb_ld(unsigned* p)              { return __hip_atomic_load(p, __ATOMIC_RELAXED, __HIP_MEMORY_SCOPE_AGENT); }
__device__ __forceinline__ unsigned xb_add(unsigned* p, unsigned v) { return __hip_atomic_fetch_add(p, v, __ATOMIC_RELAXED, __HIP_MEMORY_SCOPE_AGENT); }
__device__ __forceinline__ unsigned xb_xcc_id() { return (unsigned)__builtin_amdgcn_s_getreg((3 << 11) | 20) & 0xFu; }
#define XB_SPIN(cond, bar) do { unsigned _sp = 0; while (cond) { __builtin_amdgcn_s_sleep(1); \
    if ((++_sp & 255u) == 0u) { if (xb_ld(&(bar)[XB_TMO])) break; if (_sp > XB_SPIN_CAP) { atomicAdd(&(bar)[XB_TMO], 1u); break; } } } } while (0)
struct XcdBarrier { unsigned* bar; unsigned x; volatile LAS unsigned* st; };
__device__ __forceinline__ XcdBarrier xcd_barrier_post(unsigned* bar, volatile LAS unsigned* st) {
    XcdBarrier b; b.bar = bar; b.x = xb_xcc_id(); b.st = st;
    if (threadIdx.x == 0) (void)xb_add(&bar[XB_XCNT(b.x)], 1u);
    return b;
}
__device__ __forceinline__ void xcd_barrier_complete(unsigned* bar, unsigned x, unsigned& nloc, unsigned& nx) {
    const unsigned G = gridDim.x * gridDim.y * gridDim.z;
    unsigned sum, cnt, mine, sp = 0u;
    for (;;) {
        sum = 0u; cnt = 0u; mine = 0u;
#pragma unroll
        for (unsigned j = 0; j < 16; ++j) { const unsigned c = xb_ld(&bar[XB_XCNT(j)]); sum += c; cnt += (c > 0u) ? 1u : 0u; mine = (j == x) ? c : mine; }
        if (sum == G) break;
        __builtin_amdgcn_s_sleep(1);
        if ((++sp & 255u) == 0u) { if (xb_ld(&bar[XB_TMO])) break; if (sp > XB_SPIN_CAP) { atomicAdd(&bar[XB_TMO], 1u); break; } }
    }
    nloc = mine > 0u ? mine : 1u; nx = cnt > 0u ? cnt : 1u;
}
__device__ __forceinline__ void xcd_barrier(const XcdBarrier& b) {
    asm volatile("s_waitcnt vmcnt(0)" ::: "memory");
    __syncthreads();
    if (threadIdx.x == 0) {
        unsigned* bar = b.bar;
        __builtin_amdgcn_s_waitcnt(0);
        unsigned nloc = b.st[0], nx = b.st[1];
        if (nloc == 0u) { xcd_barrier_complete(bar, b.x, nloc, nx); b.st[0] = nloc; b.st[1] = nx; }
        const unsigned old = xb_add(&bar[XB_XSUB(b.x)], 1u);
        const unsigned gen = old / nloc;
        if (old + 1u == (gen + 1u) * nloc) {
            __builtin_amdgcn_fence(__ATOMIC_RELEASE, "agent");
            asm volatile("s_waitcnt vmcnt(0)" ::: "memory");
            const unsigned og = xb_add(&bar[XB_TOP], 1u);
            const unsigned tg = og / nx;
            if (og + 1u == (tg + 1u) * nx) xb_add(&bar[XB_TOPGEN], 1u);
            else XB_SPIN(xb_ld(&bar[XB_TOPGEN]) == tg, bar);
            __builtin_amdgcn_fence(__ATOMIC_ACQUIRE, "agent");
            xb_add(&bar[XB_XGEN(b.x)], 1u);
            asm volatile("s_waitcnt vmcnt(0)" ::: "memory");
        } else {
            XB_SPIN(xb_ld(&bar[XB_XGEN(b.x)]) == gen, bar);
            __builtin_amdgcn_fence(__ATOMIC_ACQUIRE, "agent");
            asm volatile("s_waitcnt vmcnt(0)" ::: "memory");
        }
    }
    __syncthreads();
}

struct Params {
    const float* x; const int* pos; const float* norm_g; const float* w1; const float* w3; const float* w2; const float* w_in; const float* conv_w;
    const float* pool_w; const float* pool_scale; const float* w_out; const float* w_qkv; const float* w_o; const float* final_g;
    float* out; unsigned char* ws;
    InvFreq inv;
    int ph_lo, ph_hi;
};
constexpr int LDS_BYTES = ATT_LDS + 16;
constexpr int NPHASE = 19;

__global__ void __launch_bounds__(NTHR, 2) mega_fwd(Params p) {
    extern __shared__ __attribute__((aligned(16))) unsigned char lds_raw[];
    LAS unsigned char* lds = (LAS unsigned char*)lds_raw;
    const int G = gridDim.x, bid = blockIdx.x;
    unsigned char* ws = p.ws;
    bf16_t* W13 = (bf16_t*)(ws + WS_W13); bf16_t* W2 = (bf16_t*)(ws + WS_W2); bf16_t* WA = (bf16_t*)(ws + WS_WA); bf16_t* WB = (bf16_t*)(ws + WS_WB);
    bf16_t* POOLW = (bf16_t*)(ws + WS_POOLW); float* ROPE = (float*)(ws + WS_ROPE); bf16_t* XN = (bf16_t*)(ws + WS_XN); bf16_t* BIG = (bf16_t*)(ws + WS_BIG);
    bf16_t* OG = (bf16_t*)(ws + WS_OG); bf16_t* POOLED = (bf16_t*)(ws + WS_OG); float* LSE = (float*)(ws + WS_LSE);
    float* H = p.out;
    const int lo = p.ph_lo, hi = p.ph_hi;
    volatile LAS unsigned* bst = (volatile LAS unsigned*)(lds + ATT_LDS);
    if (threadIdx.x < 4) bst[threadIdx.x] = 0u;
    __syncthreads();
    XcdBarrier xbar; xbar.bar = (unsigned*)(ws + WS_BAR); xbar.x = 0; xbar.st = bst;
    if (hi - lo > 1) xbar = xcd_barrier_post((unsigned*)(ws + WS_BAR), bst);
    if (lo < 0) cg::this_grid().sync();
#define IN(k) (lo <= (k) && (k) < hi)
#define SEAM(k) do { if (IN(k) && IN((k) + 1)) xcd_barrier(xbar); } while (0)
    const size_t WSZ = (size_t)DM * DFF;

    bf16_t* HB = (bf16_t*)(ws + WS_HB); float* RS = (float*)(ws + WS_RS);
    const float* NG = p.norm_g;
    if (IN(0)) {
        convert_w((LAS float*)lds, p.w2, DFF, DM, W2, 0, 0, nullptr, G, bid);
        convert_w((LAS float*)lds, p.w1, DM, DFF, W13, 1, 0, NG, G, bid);
        convert_w((LAS float*)lds, p.w3, DM, DFF, W13, 1, 1, NG, G, bid);
        rope_phase(p.pos, p.inv, ROPE, G, bid);
        cast_phase(p.x, HB, RS, G, bid);
    }
    SEAM(0);
    if (IN(1)) { Gemm g{HB, W13, DM, DM, SEQ, 2 * DFF, DM, 0}; StaticOrder S; S.init(SEQ, 2 * DFF, G, bid); EpiSwiglu E{BIG, DFF, RS + 0 * SEQ}; gemm_phase(lds, g, S, E); }
    SEAM(1);
    if (IN(2)) { Gemm g{BIG, W2, DFF, DFF, SEQ, DM, DFF, 0, 1}; StaticOrder S; S.init(SEQ, DM, G, bid, 4); EpiResid<true, 1> E{RS}; gemm_phase(lds, g, S, E); }
    if (IN(2)) convert_w((LAS float*)lds, p.w_in, DM, 4096, WA, 0, 0, NG + 1 * DM, G, bid);
    SEAM(2);
    if (IN(3)) { Gemm g{HB, WA, DM, DM, SEQ, 4096, DM, 0}; StaticOrder S; S.init(SEQ, 4096, G, bid); EpiBf16 E{BIG, 4096, nullptr, RS + 1 * SEQ}; gemm_phase(lds, g, S, E); }
    SEAM(3);
    if (IN(4)) convpool_phase(BIG, p.conv_w, XN, POOLED, G, bid);
    if (IN(4)) {
        convert_w((LAS float*)lds, p.w_out, DM, DM, WB, 0, 0, nullptr, G, bid);
        for (int gq = 0; gq < 4; ++gq) convert_w((LAS float*)lds, p.pool_w + (size_t)gq * 65536, 256, 256, POOLW + (size_t)gq * 65536, 0, 0, nullptr, G, bid);
    }
    SEAM(4);
    if (IN(5)) { Gemm g{POOLED, POOLW, 1024, 256, SEQ, 1024, 256, 512}; StaticOrder S; S.init(SEQ, 1024, G, bid); EpiBf16 E{XN + 1024, DM, p.pool_scale, nullptr}; gemm_phase(lds, g, S, E); }
    SEAM(5);
    if (IN(6)) { Gemm g{XN, WB, DM, DM, SEQ, DM, DM, 0}; StaticOrder S; S.init(SEQ, DM, G, bid, 4); EpiResid<false, 2> E{RS}; gemm_phase(lds, g, S, E); }
    if (IN(6)) {
        convert_w((LAS float*)lds, p.w2 + (size_t)1 * WSZ, DFF, DM, W2 + (size_t)DM * DFF, 0, 0, nullptr, G, bid);
        convert_w((LAS float*)lds, p.w1 + (size_t)1 * WSZ, DM, DFF, W13 + (size_t)2 * DFF * DM, 1, 0, NG + 2 * DM, G, bid);
        convert_w((LAS float*)lds, p.w3 + (size_t)1 * WSZ, DM, DFF, W13 + (size_t)2 * DFF * DM, 1, 1, NG + 2 * DM, G, bid);
    }
    SEAM(6);
    if (IN(7)) { Gemm g{HB, W13 + (size_t)2 * DFF * DM, DM, DM, SEQ, 2 * DFF, DM, 0}; StaticOrder S; S.init(SEQ, 2 * DFF, G, bid); EpiSwiglu E{BIG, DFF, RS + 2 * SEQ}; gemm_phase(lds, g, S, E); }
    SEAM(7);
    if (IN(8)) { Gemm g{BIG, W2 + (size_t)DM * DFF, DFF, DFF, SEQ, DM, DFF, 0, 1}; StaticOrder S; S.init(SEQ, DM, G, bid, 4); EpiResid<true, 3> E{RS}; gemm_phase(lds, g, S, E); }
    if (IN(8)) {
        convert_w((LAS float*)lds, p.w2 + (size_t)2 * WSZ, DFF, DM, W2, 0, 0, nullptr, G, bid);
        convert_w((LAS float*)lds, p.w1 + (size_t)2 * WSZ, DM, DFF, W13, 1, 0, NG + 3 * DM, G, bid);
        convert_w((LAS float*)lds, p.w3 + (size_t)2 * WSZ, DM, DFF, W13, 1, 1, NG + 3 * DM, G, bid);
    }
    SEAM(8);
    if (IN(10)) { Gemm g{HB, W13, DM, DM, SEQ, 2 * DFF, DM, 0}; StaticOrder S; S.init(SEQ, 2 * DFF, G, bid); EpiSwiglu E{BIG, DFF, RS + 3 * SEQ}; gemm_phase(lds, g, S, E); }
    SEAM(10);
    if (IN(11)) { Gemm g{BIG, W2, DFF, DFF, SEQ, DM, DFF, 0, 1}; StaticOrder S; S.init(SEQ, DM, G, bid, 4); EpiResid<true, 4> E{RS}; gemm_phase(lds, g, S, E); }
    if (IN(11)) convert_w((LAS float*)lds, p.w_qkv, DM, 6144, WA, 2, 0, NG + 4 * DM, G, bid);
    SEAM(11);
    if (IN(12)) { Gemm g{HB, WA, DM, DM, SEQ, 6144, DM, 0}; StaticOrder S; S.init(SEQ, 6144, G, bid); EpiQkv E{BIG, 6144, ROPE, RS + 4 * SEQ}; gemm_phase(lds, g, S, E); }
    SEAM(12);
    if (IN(13)) attn_phase(lds, BIG, OG, LSE, G, bid);
    SEAM(13);
    if (IN(14)) combine_phase(OG, LSE, XN, G, bid);
    if (IN(14)) convert_w((LAS float*)lds, p.w_o, DM, DM, WB, 0, 0, nullptr, G, bid);
    SEAM(14);
    if (IN(15)) { Gemm g{XN, WB, DM, DM, SEQ, DM, DM, 0}; StaticOrder S; S.init(SEQ, DM, G, bid, 4); EpiResid<false, 5> E{RS}; gemm_phase(lds, g, S, E); }
    if (IN(15)) {
        convert_w((LAS float*)lds, p.w2 + (size_t)3 * WSZ, DFF, DM, W2 + (size_t)DM * DFF, 0, 0, nullptr, G, bid);
        convert_w((LAS float*)lds, p.w1 + (size_t)3 * WSZ, DM, DFF, W13 + (size_t)2 * DFF * DM, 1, 0, NG + 5 * DM, G, bid);
        convert_w((LAS float*)lds, p.w3 + (size_t)3 * WSZ, DM, DFF, W13 + (size_t)2 * DFF * DM, 1, 1, NG + 5 * DM, G, bid);
    }
    SEAM(15);
    if (IN(16)) { Gemm g{HB, W13 + (size_t)2 * DFF * DM, DM, DM, SEQ, 2 * DFF, DM, 0}; StaticOrder S; S.init(SEQ, 2 * DFF, G, bid); EpiSwiglu E{BIG, DFF, RS + 5 * SEQ}; gemm_phase(lds, g, S, E); }
    SEAM(16);
    if (IN(17)) { Gemm g{BIG, W2 + (size_t)DM * DFF, DFF, DFF, SEQ, DM, DFF, 0, 1}; StaticOrder S; S.init(SEQ, DM, G, bid, 4); EpiResid<true, 6> E{RS}; gemm_phase(lds, g, S, E); }
    SEAM(17);
    if (IN(18)) final_norm_phase(HB, p.final_g, RS + 6 * SEQ, H, G, bid);
#undef IN
#undef SEAM
}

extern "C" void kernel_launch(void* const* d_in, const int* in_sizes, int n_in, void* d_out, int out_size, void* d_ws, size_t ws_size, hipStream_t stream) {
    static int grid = 0;
    if (grid == 0) {
        if (n_in != 14 || out_size != SEQ * DM || ws_size < WS_END) { fprintf(stderr, "kernel_launch: unexpected shapes (n_in %d, out %d, ws %zu, need %zu)\n", n_in, out_size, ws_size, (size_t)WS_END); grid = -1; return; }
        int dev = 0, cus = 0, per_cu = 0;
        hipGetDevice(&dev);
        hipDeviceGetAttribute(&cus, hipDeviceAttributeMultiprocessorCount, dev);
        if (hipFuncSetAttribute((const void*)mega_fwd, hipFuncAttributeMaxDynamicSharedMemorySize, LDS_BYTES) != hipSuccess) { fprintf(stderr, "kernel_launch: hipFuncSetAttribute failed\n"); grid = -1; return; }
        if (hipOccupancyMaxActiveBlocksPerMultiprocessor(&per_cu, (const void*)mega_fwd, NTHR, LDS_BYTES) != hipSuccess || per_cu < 1) { fprintf(stderr, "kernel_launch: occupancy query gave %d\n", per_cu); per_cu = 1; }
        (void)hipGetLastError();
        grid = cus * 1;
    }
    if (grid < 0) return;
    Params p{};
    p.x = (const float*)d_in[0]; p.pos = (const int*)d_in[1]; p.norm_g = (const float*)d_in[2]; p.w1 = (const float*)d_in[3]; p.w3 = (const float*)d_in[4]; p.w2 = (const float*)d_in[5];
    p.w_in = (const float*)d_in[6]; p.conv_w = (const float*)d_in[7]; p.pool_w = (const float*)d_in[8]; p.pool_scale = (const float*)d_in[9]; p.w_out = (const float*)d_in[10];
    p.w_qkv = (const float*)d_in[11]; p.w_o = (const float*)d_in[12]; p.final_g = (const float*)d_in[13];
    p.out = (float*)d_out; p.ws = (unsigned char*)d_ws;
    for (int i = 0; i < 16; ++i) p.inv.v[i] = (float)std::pow(500000.0, -(double)(2 * i) / 32.0);
#if MK_PER_PHASE
    for (int k = 0; k < NPHASE; ++k) {
        p.ph_lo = k; p.ph_hi = k + 1;
        hipLaunchKernelGGL(mega_fwd, dim3(grid), dim3(NTHR), LDS_BYTES, stream, p);
    }
#else
    p.ph_lo = 0; p.ph_hi = NPHASE;
    if (hipMemsetAsync((unsigned char*)d_ws + WS_BAR, 0, BAR_BYTES, stream) != hipSuccess) { fprintf(stderr, "kernel_launch: memset of barrier words failed\n"); return; }
    void* args[] = {&p};
    hipError_t e = hipLaunchCooperativeKernel((const void*)mega_fwd, dim3(grid), dim3(NTHR), args, LDS_BYTES, stream);
    if (e != hipSuccess) fprintf(stderr, "kernel_launch: cooperative launch failed: %s (grid %d)\n", hipGetErrorString(e), grid);
#endif
}
```

```cpp
#include <hip/hip_runtime.h>
#include <hip/hip_cooperative_groups.h>
#include <cstdio>
#include <cstdint>
#include <cmath>
namespace cg = cooperative_groups;

#ifndef MK_PER_PHASE
#define MK_PER_PHASE 0
#endif

#define LAS __attribute__((address_space(3)))
typedef unsigned short bf16_t;
typedef short bf16x8 __attribute__((ext_vector_type(8)));
typedef short s16x4 __attribute__((ext_vector_type(4)));
typedef float f32x4 __attribute__((ext_vector_type(4)));
typedef unsigned u32x4 __attribute__((ext_vector_type(4)));
typedef unsigned u32x2 __attribute__((ext_vector_type(2)));

constexpr int SEQ = 16384, DM = 2048, DFF = 5632, NHEAD = 16, HDIM = 128;
constexpr int NTHR = 512;
constexpr float RMS_EPS = 1e-6f;

constexpr size_t SZ_W13 = (size_t)2 * DFF * DM * 2;
constexpr size_t SZ_W2 = (size_t)DM * DFF * 2;
constexpr size_t WS_W13 = 0;
constexpr size_t WS_W2 = WS_W13 + 2 * SZ_W13;
constexpr size_t WS_WA = WS_W2 + 2 * SZ_W2;
constexpr size_t WS_WB = WS_WA + (size_t)6144 * DM * 2;
constexpr size_t WS_POOLW = WS_WB + (size_t)DM * DM * 2;
constexpr size_t WS_ROPE = WS_POOLW + (size_t)4 * 256 * 256 * 2;
constexpr size_t WS_XN = WS_ROPE + (size_t)SEQ * 32 * 4;
constexpr size_t WS_BIG = WS_XN + (size_t)SEQ * DM * 2;
constexpr size_t WS_OG = WS_BIG + (size_t)SEQ * 6144 * 2;
constexpr size_t WS_LSE = WS_OG + (size_t)3 * SEQ * DM * 2;
constexpr size_t WS_HB = WS_LSE + (size_t)3 * SEQ * 16 * 4;
constexpr size_t WS_RS = WS_HB + (size_t)SEQ * DM * 2;
constexpr size_t WS_BAR = WS_RS + (size_t)7 * SEQ * 4;
constexpr size_t BAR_BYTES = 3456 * 4;
constexpr size_t WS_END = WS_BAR + 16384;

constexpr int BM = 256, BK = 64, HALF = 128, HTB = HALF * BK * 2, STAGE_BYTES = 8 * HTB, NXCD = 8, WGM = 8;

__host__ __device__ __forceinline__ int lds_byte(int r, int c) { const int st = (r >> 4) * 2 + (c >> 5), rr = r & 15, cc = c & 31, ob = rr * 64 + cc * 2; return st * 1024 + (ob ^ (((ob >> 9) & 1) << 5)); }
__host__ __device__ __forceinline__ void stage_rc(int b, int& R, int& C) { const int st = b / 1024, sb = b % 1024, swz = sb ^ (((sb >> 9) & 1) << 5); R = (st >> 1) * 16 + swz / 64; C = (st & 1) * 32 + (swz % 64) / 2; }
__host__ __device__ __forceinline__ int perm32(int rho) { const int n = rho >> 4, i = rho & 15; return 8 * (i >> 2) + 4 * n + (i & 3); }

struct Unit { int pm, pn; };
struct Gemm { const bf16_t* A; const bf16_t* Bt; int lda, ldb, M, N, K; int a_pn_off; int rev0 = 0; };

struct StaticOrder {
    int nM, nN, nwg, G, c, wgm;
    __device__ void init(int M, int N, int G_, int c_, int wgm_ = WGM) { nM = M / BM; nN = N / BM; nwg = nM * nN; G = G_; c = c_; wgm = wgm_; }
    __device__ bool next(int i, Unit& u) const {
        const long L = (long)i * G + c; if (L >= nwg) return false;
        int wgid = (int)L; { const int q = nwg / NXCD, r = nwg % NXCD, xcd = wgid % NXCD, off = wgid / NXCD; wgid = (xcd < r ? xcd * (q + 1) : r * (q + 1) + (xcd - r) * q) + off; }
        const int nig = wgm * nN, gid = wgid / nig, fm = gid * wgm, gsz = (nM - fm) < wgm ? (nM - fm) : wgm;
        u.pm = fm + ((wgid % nig) % gsz); u.pn = (wgid % nig) / gsz; return true;
    }
};

__device__ __forceinline__ unsigned cvt_pk_bf16(float lo, float hi) { unsigned r; asm volatile("v_cvt_pk_bf16_f32 %0, %1, %2" : "=v"(r) : "v"(lo), "v"(hi)); return r; }
__device__ __forceinline__ float bf_lo(unsigned w) { return __uint_as_float(w << 16); }
__device__ __forceinline__ float bf_hi(unsigned w) { return __uint_as_float(w & 0xffff0000u); }
__device__ __forceinline__ float rs_to_r(float ss) { return __builtin_amdgcn_rsqf(ss * (1.0f / DM) + RMS_EPS); }
__device__ __forceinline__ float silu_f(float v) { return v * __builtin_amdgcn_rcpf(1.0f + __expf(-v)); }


struct EpiSwiglu {
    static constexpr bool PERM = true;
    bf16_t* O; int ldc; const float* rs;
    static constexpr bool HAS_RS = true;
    __device__ __forceinline__ void operator()(const f32x4 (&acc)[2][2][4][2], const Unit& u, int wr, int wc, int fr, int fq, const float (&rr)[2][4]) const {
        const int row0 = u.pm * BM + wr * 64 + fr, col0 = u.pn * HALF + wc * 32 + 8 * fq;
#pragma unroll
        for (int ai = 0; ai < 2; ++ai)
#pragma unroll
            for (int m = 0; m < 4; ++m) {
                const int row = row0 + ai * HALF + m * 16;
                bf16_t* rowp = O + (size_t)row * ldc + col0;
                const float r = rs_to_r(rr[ai][m]);
                const float nrl = -1.4426950408889634f * r, r2 = r * r;
                const f32x4 g0 = acc[ai][0][m][0], g1 = acc[ai][0][m][1], u0 = acc[ai][1][m][0], u1 = acc[ai][1][m][1];
                const f32x4 t0 = g0 * nrl, t1 = g1 * nrl;
                f32x4 e0, e1;
#pragma unroll
                for (int j = 0; j < 4; ++j) { e0[j] = __builtin_amdgcn_exp2f(t0[j]); e1[j] = __builtin_amdgcn_exp2f(t1[j]); }
                e0 = e0 + 1.0f; e1 = e1 + 1.0f;
#pragma unroll
                for (int j = 0; j < 4; ++j) { e0[j] = __builtin_amdgcn_rcpf(e0[j]); e1[j] = __builtin_amdgcn_rcpf(e1[j]); }
                const f32x4 v0 = (g0 * u0) * r2 * e0, v1 = (g1 * u1) * r2 * e1;
                u32x4 w; w.x = cvt_pk_bf16(v0[0], v0[1]); w.y = cvt_pk_bf16(v0[2], v0[3]); w.z = cvt_pk_bf16(v1[0], v1[1]); w.w = cvt_pk_bf16(v1[2], v1[3]);
                *(u32x4*)rowp = w;
            }
    }
};
struct EpiBf16 {
    static constexpr bool PERM = true;
    bf16_t* O; int ldc; const float* scale; const float* rs;
    static constexpr bool HAS_RS = true;
    __device__ __forceinline__ void operator()(const f32x4 (&acc)[2][2][4][2], const Unit& u, int wr, int wc, int fr, int fq, const float (&rr)[2][4]) const {
        const int row0 = u.pm * BM + wr * 64 + fr, col0 = u.pn * BM + wc * 32 + 8 * fq;
        f32x4 sv[2][2];
#pragma unroll
        for (int bj = 0; bj < 2; ++bj)
#pragma unroll
            for (int n = 0; n < 2; ++n) sv[bj][n] = scale ? *(const f32x4*)(scale + col0 + bj * HALF + 4 * n) : (f32x4){1.f, 1.f, 1.f, 1.f};
#pragma unroll
        for (int ai = 0; ai < 2; ++ai)
#pragma unroll
            for (int m = 0; m < 4; ++m) {
                const int row = row0 + ai * HALF + m * 16;
                bf16_t* rowp = O + (size_t)row * ldc + col0;
                const float r = rs ? rs_to_r(rr[ai][m]) : 1.0f;
#pragma unroll
                for (int bj = 0; bj < 2; ++bj) {
                    const f32x4 v0 = acc[ai][bj][m][0] * sv[bj][0] * r, v1 = acc[ai][bj][m][1] * sv[bj][1] * r;
                    u32x4 w; w.x = cvt_pk_bf16(v0[0], v0[1]); w.y = cvt_pk_bf16(v0[2], v0[3]); w.z = cvt_pk_bf16(v1[0], v1[1]); w.w = cvt_pk_bf16(v1[2], v1[3]);
                    *(u32x4*)(rowp + bj * HALF) = w;
                }
            }
    }
};
template <bool HALFA, int SLOT> struct EpiResid {
    static constexpr bool PERM = true;
    float* rsbase;
    static constexpr bool HAS_RS = false; const float* rs = nullptr;
    __device__ __forceinline__ void operator()(const f32x4 (&acc)[2][2][4][2], const Unit& u, int wr, int wc, int fr, int fq, const float (&)[2][4]) const {
        const int row0 = u.pm * BM + wr * 64 + fr, col0 = u.pn * BM + wc * 32 + 8 * fq;
        constexpr int ldc = DM; constexpr float alpha = HALFA ? 0.5f : 1.0f;
        float* rs = rsbase + (size_t)SLOT * SEQ;
        bf16_t* hb = (bf16_t*)((unsigned char*)rsbase - (size_t)SEQ * DM * 2);
        float ssv[2][4];
#pragma unroll
        for (int ai = 0; ai < 2; ++ai) {
            u32x4 b[4][2];
#pragma unroll
            for (int m = 0; m < 4; ++m)
#pragma unroll
                for (int bj = 0; bj < 2; ++bj) b[m][bj] = *(const u32x4*)(hb + (size_t)(row0 + ai * HALF + m * 16) * ldc + col0 + bj * HALF);
            __builtin_amdgcn_sched_barrier(0);
#pragma unroll
            for (int m = 0; m < 4; ++m) {
                const size_t off = (size_t)(row0 + ai * HALF + m * 16) * ldc + col0;
                float ss = 0.f;
#pragma unroll
                for (int bj = 0; bj < 2; ++bj) {
                    const f32x4 b0 = (f32x4){bf_lo(b[m][bj].x), bf_hi(b[m][bj].x), bf_lo(b[m][bj].y), bf_hi(b[m][bj].y)};
                    const f32x4 b1 = (f32x4){bf_lo(b[m][bj].z), bf_hi(b[m][bj].z), bf_lo(b[m][bj].w), bf_hi(b[m][bj].w)};
                    const f32x4 v0 = b0 + alpha * acc[ai][bj][m][0], v1 = b1 + alpha * acc[ai][bj][m][1];
                    ss += (v0[0] * v0[0] + v0[1] * v0[1]) + (v0[2] * v0[2] + v0[3] * v0[3]) + (v1[0] * v1[0] + v1[1] * v1[1]) + (v1[2] * v1[2] + v1[3] * v1[3]);
                    u32x4 w; w.x = cvt_pk_bf16(v0[0], v0[1]); w.y = cvt_pk_bf16(v0[2], v0[3]); w.z = cvt_pk_bf16(v1[0], v1[1]); w.w = cvt_pk_bf16(v1[2], v1[3]);
                    *(u32x4*)(hb + off + bj * HALF) = w;
                }
                ssv[ai][m] = ss;
            }
            __builtin_amdgcn_sched_barrier(0);
        }
#pragma unroll
        for (int ai = 0; ai < 2; ++ai)
#pragma unroll
            for (int m = 0; m < 4; ++m) {
                float ss = ssv[ai][m];
                ss += __shfl_xor(ss, 16); ss += __shfl_xor(ss, 32);
                if (fq == 0) (void)__hip_atomic_fetch_add(rs + row0 + ai * HALF + m * 16, ss, __ATOMIC_RELAXED, __HIP_MEMORY_SCOPE_AGENT);
            }
    }
};
struct EpiQkv {
    static constexpr bool PERM = true;
    bf16_t* O; int ldc; const float* rope; const float* rs;
    static constexpr bool HAS_RS = true;
    __device__ __forceinline__ void operator()(const f32x4 (&acc)[2][2][4][2], const Unit& u, int wr, int wc, int fr, int fq, const float (&rr)[2][4]) const {
        const int row0 = u.pm * BM + wr * 64 + fr, col0 = u.pn * BM + wc * 32 + 8 * fq;
        const bool rot = (wc == 0) && (u.pn < 16);
        f32x4 csa[2][4], sna[2][4];
#pragma unroll
        for (int ai = 0; ai < 2; ++ai)
#pragma unroll
            for (int m = 0; m < 4; ++m) {
                const int row = row0 + ai * HALF + m * 16;
                csa[ai][m] = (f32x4){1.f, 1.f, 1.f, 1.f}; sna[ai][m] = (f32x4){0.f, 0.f, 0.f, 0.f};
                if (rot) { csa[ai][m] = *(const f32x4*)(rope + (size_t)row * 32 + 4 * fq); sna[ai][m] = *(const f32x4*)(rope + (size_t)row * 32 + 16 + 4 * fq); }
            }
        __builtin_amdgcn_sched_barrier(0);
#pragma unroll
        for (int ai = 0; ai < 2; ++ai) {
#pragma unroll
            for (int m = 0; m < 4; ++m) {
                const int row = row0 + ai * HALF + m * 16;
                bf16_t* rowp = O + (size_t)row * ldc + col0;
                const float r = rs_to_r(rr[ai][m]);
                const f32x4 cs = csa[ai][m], sn = sna[ai][m];
#pragma unroll
                for (int bj = 0; bj < 2; ++bj) {
                    const f32x4 x1 = acc[ai][bj][m][0] * r, x2 = acc[ai][bj][m][1] * r;
                    const f32x4 r1 = x1 * cs - x2 * sn, r2 = x2 * cs + x1 * sn;
                    u32x4 w; w.x = cvt_pk_bf16(r1[0], r1[1]); w.y = cvt_pk_bf16(r1[2], r1[3]); w.z = cvt_pk_bf16(r2[0], r2[1]); w.w = cvt_pk_bf16(r2[2], r2[3]);
                    *(u32x4*)(rowp + bj * HALF) = w;
                }
            }
            __builtin_amdgcn_sched_barrier(0);
        }
    }
};

template <class Epi>
__device__ __forceinline__ void gemm_phase(LAS unsigned char* lds, const Gemm g, const StaticOrder S, const Epi E) {
    const int tid = threadIdx.x, wid = __builtin_amdgcn_readfirstlane(tid >> 6), lane = tid & 63, wr = wid >> 2, wc = wid & 3, fr = lane & 15, fq = lane >> 4;
    const int K = g.K, nt = K / BK;
    unsigned voffA[2], voffB[2];
#pragma unroll
    for (int i = 0; i < 2; ++i) { int R, C; stage_rc(tid * 16 + i * 8192, R, C); const int Rb = Epi::PERM ? ((R & ~31) + perm32(R & 31)) : R;
        voffA[i] = (unsigned)(R * g.lda + C) * 2u; voffB[i] = (unsigned)(Rb * g.ldb + C) * 2u; }
    const size_t kstep = (size_t)(BK * 2);
    const size_t hstepA = (size_t)HALF * g.lda * 2, hstepB = (size_t)HALF * g.ldb * 2;
    const size_t tstepA = 2 * hstepA, tstepB = 2 * hstepB;
    const unsigned ldsw = (unsigned)wid * 1024u;
    const int aoff = lds_byte(wr * 64 + fr, fq * 8), boff = lds_byte(wc * 32 + fr, fq * 8);
#define PG8_SA(b, h) (((b) * 2 + (h)) * HTB)
#define PG8_SB(b, h) ((4 + (b) * 2 + (h)) * HTB)
#define PG8_STAGE(bufoff, gbase, voff) do { _Pragma("unroll") for (int _i = 0; _i < 2; ++_i) \
        __builtin_amdgcn_global_load_lds((const unsigned*)((const char*)(gbase) + (voff)[_i]), (LAS unsigned*)(lds + (bufoff) + ldsw + _i * 8192), 16, 0, 0); } while (0)
#define PG8_LDA(dst, b, h) do { _Pragma("unroll") for (int m = 0; m < 4; ++m) _Pragma("unroll") for (int k = 0; k < 2; ++k) dst[m][k] = *(const LAS bf16x8*)(lds + PG8_SA(b, h) + aoff + m * 2048 + k * 1024); } while (0)
#define PG8_LDB(dst, b, h) do { _Pragma("unroll") for (int n = 0; n < 2; ++n) _Pragma("unroll") for (int k = 0; k < 2; ++k) dst[n][k] = *(const LAS bf16x8*)(lds + PG8_SB(b, h) + boff + n * 2048 + k * 1024); } while (0)
#define PG8_MMA(ai, bj, At, Bt) do { __builtin_amdgcn_s_setprio(1); _Pragma("unroll") for (int m = 0; m < 4; ++m) _Pragma("unroll") for (int n = 0; n < 2; ++n) _Pragma("unroll") for (int k = 0; k < 2; ++k) \
        acc[ai][bj][m][n] = __builtin_amdgcn_mfma_f32_16x16x32_bf16(Bt[n][k], At[m][k], acc[ai][bj][m][n], 0, 0, 0); __builtin_amdgcn_s_setprio(0); } while (0)
#define PG8_WAIT_V(n) asm volatile("s_waitcnt vmcnt(" #n ")" ::: "memory")
#define PG8_WAIT_L(n) asm volatile("s_waitcnt lgkmcnt(" #n ")" ::: "memory")
#define PG8_BAR __builtin_amdgcn_s_barrier()
#define PG8_SCHED __builtin_amdgcn_sched_barrier(0)
    Unit cur, nxt; int ui = 0;
    if (!S.next(0, cur)) return;
    f32x4 acc[2][2][4][2];
#pragma unroll
    for (int a = 0; a < 2; ++a)
#pragma unroll
        for (int b = 0; b < 2; ++b)
#pragma unroll
            for (int m = 0; m < 4; ++m)
#pragma unroll
                for (int n = 0; n < 2; ++n) acc[a][b][m][n] = (f32x4){0.f, 0.f, 0.f, 0.f};
    bf16x8 At[4][2], B0[2][2], B1[2][2];
    float rrc[2][4]; int rr_pm = -1;
#pragma unroll
    for (int a = 0; a < 2; ++a)
#pragma unroll
        for (int m = 0; m < 4; ++m) rrc[a][m] = 0.f;
    const long klast = (long)(nt - 1) * (long)kstep;
    long ksc = g.rev0 ? -(long)kstep : (long)kstep, ksn = ksc;
    const char* cA = (const char*)g.A + (size_t)cur.pm * tstepA + (size_t)cur.pn * g.a_pn_off + (g.rev0 ? klast : 0); const char* cB = (const char*)g.Bt + (size_t)cur.pn * tstepB + (g.rev0 ? klast : 0);
    PG8_STAGE(PG8_SB(0, 0), cB, voffB); PG8_STAGE(PG8_SB(0, 1), cB + hstepB, voffB); PG8_STAGE(PG8_SA(0, 0), cA, voffA); PG8_STAGE(PG8_SA(0, 1), cA + hstepA, voffA);
    if (wr == 1) PG8_BAR;
    PG8_WAIT_V(2); PG8_BAR;
    PG8_STAGE(PG8_SB(1, 0), cB + ksc, voffB); PG8_STAGE(PG8_SA(1, 0), cA + ksc, voffA); PG8_STAGE(PG8_SB(1, 1), cB + hstepB + ksc, voffB);
    PG8_WAIT_V(6); PG8_BAR;
    for (;;) {
        const bool has_next = S.next(ui + 1, nxt);
        const bool nrev = has_next && ((ui + 1 + g.rev0) & 1);
        ksn = has_next ? (nrev ? -(long)kstep : (long)kstep) : ksc;
        const char* nA = has_next ? (const char*)g.A + (size_t)nxt.pm * tstepA + (size_t)nxt.pn * g.a_pn_off + (nrev ? klast : 0) : cA;
        const char* nB = has_next ? (const char*)g.Bt + (size_t)nxt.pn * tstepB + (nrev ? klast : 0) : cB;
        for (int t = 0; t < nt; t += 2) {
            const bool last = (t == nt - 2);
            const char* a1 = cA + (long)(t + 1) * ksc;
            const char* a2 = last ? nA : cA + (long)(t + 2) * ksc; const char* b2 = last ? nB : cB + (long)(t + 2) * ksc;
            const long ks3 = last ? ksn : ksc;
            const char* a3 = a2 + ks3; const char* b3 = b2 + ks3;
            PG8_LDB(B0, 0, 0); PG8_LDB(B1, 0, 1); PG8_SCHED; PG8_LDA(At, 0, 0); PG8_STAGE(PG8_SA(1, 1), a1 + hstepA, voffA);
            PG8_WAIT_V(8); PG8_WAIT_L(0); PG8_BAR; PG8_MMA(0, 0, At, B0); PG8_MMA(0, 1, At, B1); PG8_BAR; PG8_SCHED;
            PG8_LDA(At, 0, 1); PG8_STAGE(PG8_SB(0, 0), b2, voffB); PG8_STAGE(PG8_SB(0, 1), b2 + hstepB, voffB); PG8_STAGE(PG8_SA(0, 0), a2, voffA);
            PG8_WAIT_V(8); PG8_WAIT_L(0); PG8_BAR; PG8_MMA(1, 0, At, B0); PG8_MMA(1, 1, At, B1); PG8_BAR; PG8_SCHED;
            PG8_LDB(B0, 1, 0); PG8_LDB(B1, 1, 1); PG8_SCHED; PG8_LDA(At, 1, 0); PG8_STAGE(PG8_SA(0, 1), a2 + hstepA, voffA);
            PG8_WAIT_V(8); PG8_WAIT_L(0); PG8_BAR; PG8_MMA(0, 0, At, B0); PG8_MMA(0, 1, At, B1); PG8_BAR; PG8_SCHED;
            PG8_LDA(At, 1, 1); PG8_STAGE(PG8_SB(1, 0), b3, voffB); PG8_STAGE(PG8_SB(1, 1), b3 + hstepB, voffB); PG8_STAGE(PG8_SA(1, 0), a3, voffA);
            PG8_WAIT_V(8); PG8_WAIT_L(0); PG8_BAR; PG8_MMA(1, 0, At, B0); PG8_MMA(1, 1, At, B1); PG8_BAR; PG8_SCHED;
        }
        if (wr == 0) PG8_BAR;
        if (Epi::HAS_RS && E.rs && cur.pm != rr_pm) {
            const int rrow0 = cur.pm * BM + wr * 64 + fr;
#pragma unroll
            for (int ai = 0; ai < 2; ++ai)
#pragma unroll
                for (int m = 0; m < 4; ++m) rrc[ai][m] = E.rs[rrow0 + ai * HALF + m * 16];
            rr_pm = cur.pm;
        }
        E(acc, cur, wr, wc, fr, fq, rrc);
        if (!has_next) break;
#pragma unroll
        for (int a = 0; a < 2; ++a)
#pragma unroll
            for (int b = 0; b < 2; ++b)
#pragma unroll
                for (int m = 0; m < 4; ++m)
#pragma unroll
                    for (int n = 0; n < 2; ++n) acc[a][b][m][n] = (f32x4){0.f, 0.f, 0.f, 0.f};
        cur = nxt; cA = nA; cB = nB; ksc = ksn; ++ui;
        if (wr == 1) PG8_BAR;
    }
    PG8_WAIT_V(0);
    PG8_BAR;
#undef PG8_SA
#undef PG8_SB
#undef PG8_STAGE
#undef PG8_LDA
#undef PG8_LDB
#undef PG8_MMA
#undef PG8_WAIT_V
#undef PG8_WAIT_L
#undef PG8_BAR
#undef PG8_SCHED
}

__device__ __forceinline__ void convert_w(LAS float* tile, const float* __restrict__ src, int K, int N, bf16_t* __restrict__ dst, int mode, int sidx, const float* __restrict__ gk, int G, int bid) {
    const int tid = threadIdx.x;
    const int tk = K / 64, tn = N / 64, ntile = tk * tn;
    const int kk = tid >> 4, n4 = (tid & 15) * 4;
    f32x4 pv[2];
    if (bid < ntile) {
        const int k0 = (bid % tk) * 64, n0 = (bid / tk) * 64;
#pragma unroll
        for (int i = 0; i < 2; ++i) pv[i] = __builtin_nontemporal_load((const f32x4*)(src + (size_t)(k0 + kk + 32 * i) * N + n0 + n4));
    }
    for (int t = bid; t < ntile; t += G) {
        const int k0 = (t % tk) * 64, n0 = (t / tk) * 64;
#pragma unroll
        for (int i = 0; i < 2; ++i) {
            const int k = kk + 32 * i;
            tile[k * 65 + n4 + 0] = pv[i][0]; tile[k * 65 + n4 + 1] = pv[i][1]; tile[k * 65 + n4 + 2] = pv[i][2]; tile[k * 65 + n4 + 3] = pv[i][3];
        }
        __syncthreads();
        if (t + G < ntile) {
            const int k1 = ((t + G) % tk) * 64, n1 = ((t + G) / tk) * 64;
#pragma unroll
            for (int i = 0; i < 2; ++i) pv[i] = __builtin_nontemporal_load((const f32x4*)(src + (size_t)(k1 + kk + 32 * i) * N + n1 + n4));
        }
        const int n = tid >> 3, k8 = (tid & 7) * 8;
        float f[8];
#pragma unroll
        for (int j = 0; j < 8; ++j) f[j] = tile[(k8 + j) * 65 + n];
        if (gk) {
            const f32x4 ga = *(const f32x4*)(gk + k0 + k8), gb = *(const f32x4*)(gk + k0 + k8 + 4);
            f[0] *= ga[0]; f[1] *= ga[1]; f[2] *= ga[2]; f[3] *= ga[3]; f[4] *= gb[0]; f[5] *= gb[1]; f[6] *= gb[2]; f[7] *= gb[3];
        }
        u32x4 w; w.x = cvt_pk_bf16(f[0], f[1]); w.y = cvt_pk_bf16(f[2], f[3]); w.z = cvt_pk_bf16(f[4], f[5]); w.w = cvt_pk_bf16(f[6], f[7]);
        const int nn = n0 + n;
        int row = nn;
        if (mode == 1) row = 256 * (nn >> 7) + 128 * sidx + (nn & 127);
        if (mode == 2 && nn < 4096 && (nn & 127) < 32) { const int d = nn & 31; row = (nn & ~31) + 8 * ((d >> 2) & 3) + 4 * (d >> 4) + (d & 3); }
        *(u32x4*)(dst + (size_t)row * K + k0 + k8) = w;
        __syncthreads();
    }
}

__device__ __forceinline__ float wave_sum(float v) {
#pragma unroll
    for (int o = 32; o >= 1; o >>= 1) v += __shfl_xor(v, o);
    return v;
}

__device__ __forceinline__ void cast_phase(const float* src, bf16_t* hb, float* rs, int G, int bid) {
    const int wave = threadIdx.x >> 6, lane = threadIdx.x & 63;
    for (int i = bid * NTHR + threadIdx.x; i < 6 * SEQ; i += G * NTHR) rs[SEQ + i] = 0.f;
    for (int row = bid * 8 + wave; row < SEQ; row += G * 8) {
        const float* p = src + (size_t)row * DM + lane * 8;
        f32x4 v[8];
#pragma unroll
        for (int i = 0; i < 4; ++i) { v[2 * i] = __builtin_nontemporal_load((const f32x4*)(p + i * 512)); v[2 * i + 1] = __builtin_nontemporal_load((const f32x4*)(p + i * 512 + 4)); }
        float ss = 0.f;
#pragma unroll
        for (int i = 0; i < 8; ++i) ss += v[i][0] * v[i][0] + v[i][1] * v[i][1] + v[i][2] * v[i][2] + v[i][3] * v[i][3];
        ss = wave_sum(ss);
        if (lane == 0) rs[row] = ss;
#pragma unroll
        for (int i = 0; i < 4; ++i) {
            const f32x4 a = v[2 * i], b = v[2 * i + 1];
            u32x4 w; w.x = cvt_pk_bf16(a[0], a[1]); w.y = cvt_pk_bf16(a[2], a[3]); w.z = cvt_pk_bf16(b[0], b[1]); w.w = cvt_pk_bf16(b[2], b[3]);
            *(u32x4*)(hb + (size_t)row * DM + i * 512 + lane * 8) = w;
        }
    }
}
__device__ __forceinline__ void final_norm_phase(const bf16_t* __restrict__ hb, const float* __restrict__ g, const float* __restrict__ rs, float* __restrict__ dst, int G, int bid) {
    const int wave = threadIdx.x >> 6, lane = threadIdx.x & 63;
    for (int row = bid * 8 + wave; row < SEQ; row += G * 8) {
        const bf16_t* p = hb + (size_t)row * DM + lane * 8;
        u32x4 v[4];
#pragma unroll
        for (int i = 0; i < 4; ++i) v[i] = *(const u32x4*)(p + i * 512);
        const float r = rs_to_r(rs[row]);
        float* q = dst + (size_t)row * DM + lane * 8;
#pragma unroll
        for (int i = 0; i < 4; ++i) {
            const f32x4 g0 = *(const f32x4*)(g + i * 512 + lane * 8), g1 = *(const f32x4*)(g + i * 512 + lane * 8 + 4);
            const f32x4 a = (f32x4){bf_lo(v[i].x), bf_hi(v[i].x), bf_lo(v[i].y), bf_hi(v[i].y)}, b = (f32x4){bf_lo(v[i].z), bf_hi(v[i].z), bf_lo(v[i].w), bf_hi(v[i].w)};
            *(f32x4*)(q + i * 512) = a * r * g0; *(f32x4*)(q + i * 512 + 4) = b * r * g1;
        }
    }
}

struct InvFreq { float v[16]; };
__device__ __forceinline__ void rope_phase(const int* pos, const InvFreq& inv, float* rope, int G, int bid) {
    for (int idx = bid * NTHR + threadIdx.x; idx < SEQ * 16; idx += G * NTHR) {
        const int t = idx >> 4, i = idx & 15;
        float fv = inv.v[0];
#pragma unroll
        for (int j = 1; j < 16; ++j) fv = (i == j) ? inv.v[j] : fv;
        const float ang = (float)pos[t] * fv;
        const double rev = (double)ang * 0.15915494309189533577;
        const float fr = (float)(rev - rint(rev));
        rope[(size_t)t * 32 + i] = __builtin_amdgcn_cosf(fr);
        rope[(size_t)t * 32 + 16 + i] = __builtin_amdgcn_sinf(fr);
    }
}

__device__ __forceinline__ void convpool_phase(const bf16_t* __restrict__ z, const float* __restrict__ conv_w, bf16_t* __restrict__ ycat, bf16_t* __restrict__ pooled, int G, int bid) {
#pragma unroll 2
    for (int idx = bid * NTHR + threadIdx.x; idx < SEQ * 128; idx += G * NTHR) {
        const int t = idx >> 7, c0 = (idx & 127) * 8;
        u32x4 gc[3], hv[3];
#pragma unroll
        for (int j = 0; j < 3; ++j) {
            const int tt = t - 2 + j, tc = tt < 0 ? 0 : tt;
            gc[j] = *(const u32x4*)(z + (size_t)tc * 4096 + 1024 + c0); hv[j] = *(const u32x4*)(z + (size_t)tc * 4096 + 2048 + c0);
        }
        const u32x4 gb = *(const u32x4*)(z + (size_t)t * 4096 + c0);
        float a[8];
#pragma unroll
        for (int e = 0; e < 8; ++e) a[e] = 0.f;
#pragma unroll
        for (int j = 0; j < 3; ++j) {
            const float wm = (t - 2 + j) >= 0 ? 1.f : 0.f;
            const f32x4 w0 = *(const f32x4*)(conv_w + j * 1024 + c0) * wm, w1 = *(const f32x4*)(conv_w + j * 1024 + c0 + 4) * wm;
            a[0] += w0[0] * (bf_lo(gc[j].x) * bf_lo(hv[j].x)); a[1] += w0[1] * (bf_hi(gc[j].x) * bf_hi(hv[j].x));
            a[2] += w0[2] * (bf_lo(gc[j].y) * bf_lo(hv[j].y)); a[3] += w0[3] * (bf_hi(gc[j].y) * bf_hi(hv[j].y));
            a[4] += w1[0] * (bf_lo(gc[j].z) * bf_lo(hv[j].z)); a[5] += w1[1] * (bf_hi(gc[j].z) * bf_hi(hv[j].z));
            a[6] += w1[2] * (bf_lo(gc[j].w) * bf_lo(hv[j].w)); a[7] += w1[3] * (bf_hi(gc[j].w) * bf_hi(hv[j].w));
        }
        u32x4 w;
        w.x = cvt_pk_bf16(bf_lo(gb.x) * a[0], bf_hi(gb.x) * a[1]); w.y = cvt_pk_bf16(bf_lo(gb.y) * a[2], bf_hi(gb.y) * a[3]);
        w.z = cvt_pk_bf16(bf_lo(gb.z) * a[4], bf_hi(gb.z) * a[5]); w.w = cvt_pk_bf16(bf_lo(gb.w) * a[6], bf_hi(gb.w) * a[7]);
        *(u32x4*)(ycat + (size_t)t * DM + c0) = w;
    }
    for (int idx = bid * NTHR + threadIdx.x; idx < (SEQ / 4) * 128; idx += G * NTHR) {
        const int t0 = (idx >> 7) * 4, c0 = (idx & 127) * 8, win = 2 << (c0 >> 8);
        u32x4 uv[19];
#pragma unroll
        for (int i = 0; i < 19; ++i) { const int row = t0 - 15 + i, rc = row < 0 ? 0 : row; uv[i] = *(const u32x4*)(z + (size_t)rc * 4096 + 3072 + c0); }
        float a[4][8];
#pragma unroll
        for (int k = 0; k < 4; ++k)
#pragma unroll
            for (int e = 0; e < 8; ++e) a[k][e] = 0.f;
#pragma unroll
        for (int i = 0; i < 19; ++i) {
            const int d = i - 15;
            const float x0 = bf_lo(uv[i].x), x1 = bf_hi(uv[i].x), x2 = bf_lo(uv[i].y), x3 = bf_hi(uv[i].y), x4 = bf_lo(uv[i].z), x5 = bf_hi(uv[i].z), x6 = bf_lo(uv[i].w), x7 = bf_hi(uv[i].w);
#pragma unroll
            for (int k = 0; k < 4; ++k) {
                if (d <= k) {
                    const float mk = (d >= k - win + 1 && t0 + d >= 0) ? 1.f : 0.f;
                    a[k][0] += mk * x0; a[k][1] += mk * x1; a[k][2] += mk * x2; a[k][3] += mk * x3; a[k][4] += mk * x4; a[k][5] += mk * x5; a[k][6] += mk * x6; a[k][7] += mk * x7;
                }
            }
        }
#pragma unroll
        for (int k = 0; k < 4; ++k) {
            const int t = t0 + k, n = (t + 1) < win ? (t + 1) : win;
            const float rn = 1.0f / (float)n;
            const u32x4 u0 = uv[15 + k];
            u32x4 w;
            w.x = cvt_pk_bf16(a[k][0] * rn - bf_lo(u0.x), a[k][1] * rn - bf_hi(u0.x)); w.y = cvt_pk_bf16(a[k][2] * rn - bf_lo(u0.y), a[k][3] * rn - bf_hi(u0.y));
            w.z = cvt_pk_bf16(a[k][4] * rn - bf_lo(u0.z), a[k][5] * rn - bf_hi(u0.z)); w.w = cvt_pk_bf16(a[k][6] * rn - bf_lo(u0.w), a[k][7] * rn - bf_hi(u0.w));
            *(u32x4*)(pooled + (size_t)t * 1024 + c0) = w;
        }
    }
}

constexpr int KP = 272;
constexpr int ATT_LDS = 2 * 256 * KP;
__device__ __forceinline__ void attn_phase(LAS unsigned char* lds, const bf16_t* qkv, bf16_t* og, float* lse, int G, int bid) {
    const int tid = threadIdx.x, wid = __builtin_amdgcn_readfirstlane(tid >> 6), lane = tid & 63, fr = lane & 15, fq = lane >> 4;
    LAS unsigned char* Ks = lds; LAS unsigned char* Vs = lds + 256 * KP;
    const float sl2 = 0.08838834764831845f * 1.4426950408889634f;
    const int srow = tid >> 4, sch = tid & 15;
    constexpr int NSEG = 3 * 16 * 16, SEGLEN = 8;
    for (int seg = bid; seg < NSEG; seg += G) {
        const int h8 = seg & 7, tq = seg >> 3, sidx = tq & 15, uq = tq >> 4, gb = uq % 3, h = (uq / 3) * 8 + h8;
        const int sh = 2 * gb, dil = 1 << sh, r = sidx & (dil - 1), blk0 = (sidx >> sh) * SEGLEN;
        const bf16_t* kbase = qkv + 2048 + h * 128 + sch * 8;
        u32x4 rk[4], rv[4]; bf16x8 rq[4];
        __syncthreads();
        if (blk0 > 0) {
#pragma unroll
            for (int i = 0; i < 4; ++i) { const int c = srow + 32 * i; const size_t pos = (size_t)(((blk0 - 1) * 128 + c) * dil + r);
                rk[i] = *(const u32x4*)(kbase + pos * 6144); rv[i] = *(const u32x4*)(kbase + pos * 6144 + 2048); }
#pragma unroll
            for (int i = 0; i < 4; ++i) { const int c = srow + 32 * i; *(LAS u32x4*)(Ks + (128 + c) * KP + sch * 16) = rk[i]; *(LAS u32x4*)(Vs + (128 + c) * KP + sch * 16) = rv[i]; }
        }
#pragma unroll
        for (int i = 0; i < 4; ++i) { const int c = srow + 32 * i; const size_t pos = (size_t)((blk0 * 128 + c) * dil + r);
            rk[i] = *(const u32x4*)(kbase + pos * 6144); rv[i] = *(const u32x4*)(kbase + pos * 6144 + 2048); }
#pragma unroll
        for (int i = 0; i < 4; ++i) { const int c = srow + 32 * i; *(LAS u32x4*)(Ks + c * KP + sch * 16) = rk[i]; *(LAS u32x4*)(Vs + c * KP + sch * 16) = rv[i]; }
        {
            const size_t posq0 = (size_t)((blk0 * 128 + wid * 16 + fr) * dil + r);
#pragma unroll
            for (int kk = 0; kk < 4; ++kk) rq[kk] = *(const bf16x8*)(qkv + posq0 * 6144 + h * 128 + kk * 32 + fq * 8);
        }
        for (int j = 0; j < SEGLEN; ++j) {
            const int blk = blk0 + j, cs = j & 1, ps = cs ^ 1;
            bf16x8 Q[4];
#pragma unroll
            for (int kk = 0; kk < 4; ++kk) Q[kk] = rq[kk];
            __syncthreads();
            if (j + 1 < SEGLEN) {
#pragma unroll
                for (int i = 0; i < 4; ++i) { const int c = srow + 32 * i; const size_t pos = (size_t)(((blk + 1) * 128 + c) * dil + r);
                    rk[i] = *(const u32x4*)(kbase + pos * 6144); rv[i] = *(const u32x4*)(kbase + pos * 6144 + 2048); }
                const size_t posqn = (size_t)(((blk + 1) * 128 + wid * 16 + fr) * dil + r);
#pragma unroll
                for (int kk = 0; kk < 4; ++kk) rq[kk] = *(const bf16x8*)(qkv + posqn * 6144 + h * 128 + kk * 32 + fq * 8);
            }
            const int a = wid * 16 + fr;
            const size_t posq = (size_t)((blk * 128 + a) * dil + r);
            LAS unsigned char* Kp = Ks + ps * 128 * KP; LAS unsigned char* Kc = Ks + cs * 128 * KP;
            LAS unsigned char* Vp = Vs + ps * 128 * KP; LAS unsigned char* Vc = Vs + cs * 128 * KP;
            f32x4 sc[16];
#pragma unroll
            for (int s = 0; s < 16; ++s) {
                sc[s] = (f32x4){0.f, 0.f, 0.f, 0.f};
                if (s >= wid && s <= wid + 8 && (s >= 8 || blk > 0)) {
                    LAS unsigned char* kb = (s < 8 ? Kp : Kc) + (16 * (s & 7) + fr) * KP + 16 * fq;
#pragma unroll
                    for (int kk = 0; kk < 4; ++kk) {
                        const bf16x8 kf = *(const LAS bf16x8*)(kb + 64 * kk);
                        sc[s] = __builtin_amdgcn_mfma_f32_16x16x32_bf16(kf, Q[kk], sc[s], 0, 0, 0);
                    }
                }
            }
            float mx = -3.0e38f;
#pragma unroll
            for (int s = 0; s < 16; ++s) {
                if (s >= wid && s <= wid + 8 && (s >= 8 || blk > 0)) {
#pragma unroll
                    for (int jj = 0; jj < 4; ++jj) {
                        const int c = 16 * s + 4 * fq + jj;
                        const bool valid = (s < 8) ? (c >= a) : (c - 128 <= a);
                        const float v = valid ? sc[s][jj] * sl2 : -1.0e30f;
                        sc[s][jj] = v; mx = fmaxf(mx, v);
                    }
                }
            }
            mx = fmaxf(mx, __shfl_xor(mx, 16)); mx = fmaxf(mx, __shfl_xor(mx, 32));
            float l = 0.f;
#pragma unroll
            for (int s = 0; s < 16; ++s) {
                if (s >= wid && s <= wid + 8 && (s >= 8 || blk > 0)) {
#pragma unroll
                    for (int jj = 0; jj < 4; ++jj) { const float pp = __builtin_amdgcn_exp2f(sc[s][jj] - mx); sc[s][jj] = pp; l += pp; }
                } else sc[s] = (f32x4){0.f, 0.f, 0.f, 0.f};
            }
            l += __shfl_xor(l, 16); l += __shfl_xor(l, 32);
            f32x4 o[8];
#pragma unroll
            for (int dt = 0; dt < 8; ++dt) o[dt] = (f32x4){0.f, 0.f, 0.f, 0.f};
#pragma unroll
            for (int ks = 0; ks < 8; ++ks) {
                if (2 * ks + 1 >= wid && 2 * ks <= wid + 8 && (ks >= 4 || blk > 0)) {
                    union { u32x4 u; bf16x8 b; } P;
                    P.u.x = cvt_pk_bf16(sc[2 * ks][0], sc[2 * ks][1]); P.u.y = cvt_pk_bf16(sc[2 * ks][2], sc[2 * ks][3]);
                    P.u.z = cvt_pk_bf16(sc[2 * ks + 1][0], sc[2 * ks + 1][1]); P.u.w = cvt_pk_bf16(sc[2 * ks + 1][2], sc[2 * ks + 1][3]);
                    LAS unsigned char* vb = (ks < 4 ? Vp : Vc) + (32 * (ks & 3) + 4 * fq + (fr >> 2)) * KP + 8 * (fr & 3);
#pragma unroll
                    for (int dt = 0; dt < 8; ++dt) {
                        const s16x4 v0 = __builtin_amdgcn_ds_read_tr16_b64_v4i16((LAS s16x4*)(vb + 32 * dt));
                        const s16x4 v1 = __builtin_amdgcn_ds_read_tr16_b64_v4i16((LAS s16x4*)(vb + 16 * KP + 32 * dt));
                        const bf16x8 vf = __builtin_shufflevector(v0, v1, 0, 1, 2, 3, 4, 5, 6, 7);
                        o[dt] = __builtin_amdgcn_mfma_f32_16x16x32_bf16(vf, P.b, o[dt], 0, 0, 0);
                    }
                }
            }
            const float inv = 1.0f / l;
            bf16_t* op = og + (size_t)gb * SEQ * DM + posq * DM + h * 128 + ((fq & 1) ? 16 + 4 * (fq - 1) : 4 * fq);
#pragma unroll
            for (int dt = 0; dt < 8; dt += 2) {
                const unsigned ax = cvt_pk_bf16(o[dt][0] * inv, o[dt][1] * inv), ay = cvt_pk_bf16(o[dt][2] * inv, o[dt][3] * inv);
                const unsigned bx = cvt_pk_bf16(o[dt + 1][0] * inv, o[dt + 1][1] * inv), by = cvt_pk_bf16(o[dt + 1][2] * inv, o[dt + 1][3] * inv);
                const auto sx = __builtin_amdgcn_permlane16_swap(ax, bx, false, false);
                const auto sy = __builtin_amdgcn_permlane16_swap(ay, by, false, false);
                u32x4 w; w.x = sx[0]; w.y = sy[0]; w.z = sx[1]; w.w = sy[1];
                *(u32x4*)(op + 16 * dt) = w;
            }
            if (fq == 0) lse[(size_t)gb * SEQ * 16 + posq * 16 + h] = mx * 0.6931471805599453f + __logf(l);
            if (j + 1 < SEGLEN) {
                __syncthreads();
#pragma unroll
                for (int i = 0; i < 4; ++i) { const int c = srow + 32 * i; *(LAS u32x4*)(Ks + (ps * 128 + c) * KP + sch * 16) = rk[i]; *(LAS u32x4*)(Vs + (ps * 128 + c) * KP + sch * 16) = rv[i]; }
            }
        }
    }
}

__device__ __forceinline__ void combine_phase(const bf16_t* __restrict__ og, const float* __restrict__ lse, bf16_t* __restrict__ dst, int G, int bid) {
#pragma unroll 4
    for (int idx = bid * NTHR + threadIdx.x; idx < SEQ * 256; idx += G * NTHR) {
        const int t = idx >> 8, oc = idx & 255, h = oc >> 4;
        const float l0 = lse[(size_t)t * 16 + h], l1 = lse[(size_t)SEQ * 16 + (size_t)t * 16 + h], l2 = lse[(size_t)2 * SEQ * 16 + (size_t)t * 16 + h];
        const float mx = fmaxf(l0, fmaxf(l1, l2));
        float w0 = __expf(l0 - mx), w1 = __expf(l1 - mx), w2 = __expf(l2 - mx);
        const float inv = 1.0f / (w0 + w1 + w2); w0 *= inv; w1 *= inv; w2 *= inv;
        const size_t off = (size_t)t * DM + oc * 8;
        const u32x4 a = *(const u32x4*)(og + off), b = *(const u32x4*)(og + (size_t)SEQ * DM + off), c = *(const u32x4*)(og + (size_t)2 * SEQ * DM + off);
        u32x4 w;
        w.x = cvt_pk_bf16(w0 * bf_lo(a.x) + w1 * bf_lo(b.x) + w2 * bf_lo(c.x), w0 * bf_hi(a.x) + w1 * bf_hi(b.x) + w2 * bf_hi(c.x));
        w.y = cvt_pk_bf16(w0 * bf_lo(a.y) + w1 * bf_lo(b.y) + w2 * bf_lo(c.y), w0 * bf_hi(a.y) + w1 * bf_hi(b.y) + w2 * bf_hi(c.y));
        w.z = cvt_pk_bf16(w0 * bf_lo(a.z) + w1 * bf_lo(b.z) + w2 * bf_lo(c.z), w0 * bf_hi(a.z) + w1 * bf_hi(b.z) + w2 * bf_hi(c.z));
        w.w = cvt_pk_bf16(w0 * bf_lo(a.w) + w1 * bf_lo(b.w) + w2 * bf_lo(c.w), w0 * bf_hi(a.w) + w1 * bf_hi(b.w) + w2 * bf_hi(c.w));
        *(u32x4*)(dst + off) = w;
    }
}


#define XB_TMO      128
#define XB_XCNT(j)  (256  + 64 * (j))
#define XB_XSUB(j)  (1280 + 64 * (j))
#define XB_XGEN(j)  (2304 + 64 * (j))
#define XB_TOP      3328
#define XB_TOPGEN   3392
#define XCD_BAR_WORDS 3456
#define XB_SPIN_CAP (1u << 22)
__device__ __forceinline__ unsigned xb_ld(unsigned* p)              { return __hip_atomic_load(p, __ATOMIC_RELAXED, __HIP_MEMORY_SCOPE_AGENT); }
__device__ __forceinline__ unsigned xb_add(unsigned* p, unsigned v) { return __hip_atomic_fetch_add(p, v, __ATOMIC_RELAXED, __HIP_MEMORY_SCOPE_AGENT); }
__device__ __forceinline__ unsigned xb_xcc_id() { return (unsigned)__builtin_amdgcn_s_getreg((3 << 11) | 20) & 0xFu; }
#define XB_SPIN(cond, bar) do { unsigned _sp = 0; while (cond) { __builtin_amdgcn_s_sleep(1); \
    if ((++_sp & 255u) == 0u) { if (xb_ld(&(bar)[XB_TMO])) break; if (_sp > XB_SPIN_CAP) { atomicAdd(&(bar)[XB_TMO], 1u); break; } } } } while (0)
struct XcdBarrier { unsigned* bar; unsigned x; volatile LAS unsigned* st; };
__device__ __forceinline__ XcdBarrier xcd_barrier_post(unsigned* bar, volatile LAS unsigned* st) {
    XcdBarrier b; b.bar = bar; b.x = xb_xcc_id(); b.st = st;
    if (threadIdx.x == 0) (void)xb_add(&bar[XB_XCNT(b.x)], 1u);
    return b;
}
__device__ __forceinline__ void xcd_barrier_complete(unsigned* bar, unsigned x, unsigned& nloc, unsigned& nx) {
    const unsigned G = gridDim.x * gridDim.y * gridDim.z;
    unsigned sum, cnt, mine, sp = 0u;
    for (;;) {
        sum = 0u; cnt = 0u; mine = 0u;
#pragma unroll
        for (unsigned j = 0; j < 16; ++j) { const unsigned c = xb_ld(&bar[XB_XCNT(j)]); sum += c; cnt += (c > 0u) ? 1u : 0u; mine = (j == x) ? c : mine; }
        if (sum == G) break;
        __builtin_amdgcn_s_sleep(1);
        if ((++sp & 255u) == 0u) { if (xb_ld(&bar[XB_TMO])) break; if (sp > XB_SPIN_CAP) { atomicAdd(&bar[XB_TMO], 1u); break; } }
    }
    nloc = mine > 0u ? mine : 1u; nx = cnt > 0u ? cnt : 1u;
}
__device__ __forceinline__ void xcd_barrier(const XcdBarrier& b) {
    asm volatile("s_waitcnt vmcnt(0)" ::: "memory");
    __syncthreads();
    if (threadIdx.x == 0) {
        unsigned* bar = b.bar;
        __builtin_amdgcn_s_waitcnt(0);
        unsigned nloc = b.st[0], nx = b.st[1];
        if (nloc == 0u) { xcd_barrier_complete(bar, b.x, nloc, nx); b.st[0] = nloc; b.st[1] = nx; }
        const unsigned old = xb_add(&bar[XB_XSUB(b.x)], 1u);
        const unsigned gen = old / nloc;
        if (old + 1u == (gen + 1u) * nloc) {
            __builtin_amdgcn_fence(__ATOMIC_RELEASE, "agent");
            asm volatile("s_waitcnt vmcnt(0)" ::: "memory");
            const unsigned og = xb_add(&bar[XB_TOP], 1u);
            const unsigned tg = og / nx;
            if (og + 1u == (tg + 1u) * nx) xb_add(&bar[XB_TOPGEN], 1u);
            else XB_SPIN(xb_ld(&bar[XB_TOPGEN]) == tg, bar);
            __builtin_amdgcn_fence(__ATOMIC_ACQUIRE, "agent");
            xb_add(&bar[XB_XGEN(b.x)], 1u);
            asm volatile("s_waitcnt vmcnt(0)" ::: "memory");
        } else {
            XB_SPIN(xb_ld(&bar[XB_XGEN(b.x)]) == gen, bar);
            __builtin_amdgcn_fence(__ATOMIC_ACQUIRE, "agent");
            asm volatile("s_waitcnt vmcnt(0)" ::: "memory");
        }
    }
    __syncthreads();
}

struct Params {
    const float* x; const int* pos; const float* norm_g; const float* w1; const float* w3; const float* w2; const float* w_in; const float* conv_w;
    const float* pool_w; const float* pool_scale; const float* w_out; const float* w_qkv; const float* w_o; const float* final_g;
    float* out; unsigned char* ws;
    InvFreq inv;
    int ph_lo, ph_hi;
};
constexpr int LDS_BYTES = ATT_LDS + 16;
constexpr int NPHASE = 19;

__global__ void __launch_bounds__(NTHR, 2) mega_fwd(Params p) {
    extern __shared__ __attribute__((aligned(16))) unsigned char lds_raw[];
    LAS unsigned char* lds = (LAS unsigned char*)lds_raw;
    const int G = gridDim.x, bid = blockIdx.x;
    unsigned char* ws = p.ws;
    bf16_t* W13 = (bf16_t*)(ws + WS_W13); bf16_t* W2 = (bf16_t*)(ws + WS_W2); bf16_t* WA = (bf16_t*)(ws + WS_WA); bf16_t* WB = (bf16_t*)(ws + WS_WB);
    bf16_t* POOLW = (bf16_t*)(ws + WS_POOLW); float* ROPE = (float*)(ws + WS_ROPE); bf16_t* XN = (bf16_t*)(ws + WS_XN); bf16_t* BIG = (bf16_t*)(ws + WS_BIG);
    bf16_t* OG = (bf16_t*)(ws + WS_OG); bf16_t* POOLED = (bf16_t*)(ws + WS_OG); float* LSE = (float*)(ws + WS_LSE);
    float* H = p.out;
    const int lo = p.ph_lo, hi = p.ph_hi;
    volatile LAS unsigned* bst = (volatile LAS unsigned*)(lds + ATT_LDS);
    if (threadIdx.x < 4) bst[threadIdx.x] = 0u;
    __syncthreads();
    XcdBarrier xbar; xbar.bar = (unsigned*)(ws + WS_BAR); xbar.x = 0; xbar.st = bst;
    if (hi - lo > 1) xbar = xcd_barrier_post((unsigned*)(ws + WS_BAR), bst);
    if (lo < 0) cg::this_grid().sync();
#define IN(k) (lo <= (k) && (k) < hi)
#define SEAM(k) do { if (IN(k) && IN((k) + 1)) xcd_barrier(xbar); } while (0)
    const size_t WSZ = (size_t)DM * DFF;

    bf16_t* HB = (bf16_t*)(ws + WS_HB); float* RS = (float*)(ws + WS_RS);
    const float* NG = p.norm_g;
    if (IN(0)) {
        convert_w((LAS float*)lds, p.w2, DFF, DM, W2, 0, 0, nullptr, G, bid);
        convert_w((LAS float*)lds, p.w1, DM, DFF, W13, 1, 0, NG, G, bid);
        convert_w((LAS float*)lds, p.w3, DM, DFF, W13, 1, 1, NG, G, bid);
        rope_phase(p.pos, p.inv, ROPE, G, bid);
        cast_phase(p.x, HB, RS, G, bid);
    }
    SEAM(0);
    if (IN(1)) { Gemm g{HB, W13, DM, DM, SEQ, 2 * DFF, DM, 0}; StaticOrder S; S.init(SEQ, 2 * DFF, G, bid); EpiSwiglu E{BIG, DFF, RS + 0 * SEQ}; gemm_phase(lds, g, S, E); }
    SEAM(1);
    if (IN(2)) { Gemm g{BIG, W2, DFF, DFF, SEQ, DM, DFF, 0, 1}; StaticOrder S; S.init(SEQ, DM, G, bid, 4); EpiResid<true, 1> E{RS}; gemm_phase(lds, g, S, E); }
    if (IN(2)) convert_w((LAS float*)lds, p.w_in, DM, 4096, WA, 0, 0, NG + 1 * DM, G, bid);
    SEAM(2);
    if (IN(3)) { Gemm g{HB, WA, DM, DM, SEQ, 4096, DM, 0}; StaticOrder S; S.init(SEQ, 4096, G, bid); EpiBf16 E{BIG, 4096, nullptr, RS + 1 * SEQ}; gemm_phase(lds, g, S, E); }
    SEAM(3);
    if (IN(4)) convpool_phase(BIG, p.conv_w, XN, POOLED, G, bid);
    if (IN(4)) {
        convert_w((LAS float*)lds, p.w_out, DM, DM, WB, 0, 0, nullptr, G, bid);
        for (int gq = 0; gq < 4; ++gq) convert_w((LAS float*)lds, p.pool_w + (size_t)gq * 65536, 256, 256, POOLW + (size_t)gq * 65536, 0, 0, nullptr, G, bid);
    }
    SEAM(4);
    if (IN(5)) { Gemm g{POOLED, POOLW, 1024, 256, SEQ, 1024, 256, 512}; StaticOrder S; S.init(SEQ, 1024, G, bid); EpiBf16 E{XN + 1024, DM, p.pool_scale, nullptr}; gemm_phase(lds, g, S, E); }
    SEAM(5);
    if (IN(6)) { Gemm g{XN, WB, DM, DM, SEQ, DM, DM, 0}; StaticOrder S; S.init(SEQ, DM, G, bid, 4); EpiResid<false, 2> E{RS}; gemm_phase(lds, g, S, E); }
    if (IN(6)) {
        convert_w((LAS float*)lds, p.w2 + (size_t)1 * WSZ, DFF, DM, W2 + (size_t)DM * DFF, 0, 0, nullptr, G, bid);
        convert_w((LAS float*)lds, p.w1 + (size_t)1 * WSZ, DM, DFF, W13 + (size_t)2 * DFF * DM, 1, 0, NG + 2 * DM, G, bid);
        convert_w((LAS float*)lds, p.w3 + (size_t)1 * WSZ, DM, DFF, W13 + (size_t)2 * DFF * DM, 1, 1, NG + 2 * DM, G, bid);
    }
    SEAM(6);
    if (IN(7)) { Gemm g{HB, W13 + (size_t)2 * DFF * DM, DM, DM, SEQ, 2 * DFF, DM, 0}; StaticOrder S; S.init(SEQ, 2 * DFF, G, bid); EpiSwiglu E{BIG, DFF, RS + 2 * SEQ}; gemm_phase(lds, g, S, E); }
    SEAM(7);
    if (IN(8)) { Gemm g{BIG, W2 + (size_t)DM * DFF, DFF, DFF, SEQ, DM, DFF, 0, 1}; StaticOrder S; S.init(SEQ, DM, G, bid, 4); EpiResid<true, 3> E{RS}; gemm_phase(lds, g, S, E); }
    if (IN(8)) {
        convert_w((LAS float*)lds, p.w2 + (size_t)2 * WSZ, DFF, DM, W2, 0, 0, nullptr, G, bid);
        convert_w((LAS float*)lds, p.w1 + (size_t)2 * WSZ, DM, DFF, W13, 1, 0, NG + 3 * DM, G, bid);
        convert_w((LAS float*)lds, p.w3 + (size_t)2 * WSZ, DM, DFF, W13, 1, 1, NG + 3 * DM, G, bid);
    }
    SEAM(8);
    if (IN(10)) { Gemm g{HB, W13, DM, DM, SEQ, 2 * DFF, DM, 0}; StaticOrder S; S.init(SEQ, 2 * DFF, G, bid); EpiSwiglu E{BIG, DFF, RS + 3 * SEQ}; gemm_phase(lds, g, S, E); }
    SEAM(10);
    if (IN(11)) { Gemm g{BIG, W2, DFF, DFF, SEQ, DM, DFF, 0, 1}; StaticOrder S; S.init(SEQ, DM, G, bid, 4); EpiResid<true, 4> E{RS}; gemm_phase(lds, g, S, E); }
    if (IN(11)) convert_w((LAS float*)lds, p.w_qkv, DM, 6144, WA, 2, 0, NG + 4 * DM, G, bid);
    SEAM(11);
    if (IN(12)) { Gemm g{HB, WA, DM, DM, SEQ, 6144, DM, 0}; StaticOrder S; S.init(SEQ, 6144, G, bid); EpiQkv E{BIG, 6144, ROPE, RS + 4 * SEQ}; gemm_phase(lds, g, S, E); }
    SEAM(12);
    if (IN(13)) attn_phase(lds, BIG, OG, LSE, G, bid);
    SEAM(13);
    if (IN(14)) combine_phase(OG, LSE, XN, G, bid);
    if (IN(14)) convert_w((LAS float*)lds, p.w_o, DM, DM, WB, 0, 0, nullptr, G, bid);
    SEAM(14);
    if (IN(15)) { Gemm g{XN, WB, DM, DM, SEQ, DM, DM, 0}; StaticOrder S; S.init(SEQ, DM, G, bid, 4); EpiResid<false, 5> E{RS}; gemm_phase(lds, g, S, E); }
    if (IN(15)) {
        convert_w((LAS float*)lds, p.w2 + (size_t)3 * WSZ, DFF, DM, W2 + (size_t)DM * DFF, 0, 0, nullptr, G, bid);
        convert_w((LAS float*)lds, p.w1 + (size_t)3 * WSZ, DM, DFF, W13 + (size_t)2 * DFF * DM, 1, 0, NG + 5 * DM, G, bid);
        convert_w((LAS float*)lds, p.w3 + (size_t)3 * WSZ, DM, DFF, W13 + (size_t)2 * DFF * DM, 1, 1, NG + 5 * DM, G, bid);
    }
    SEAM(15);
    if (IN(16)) { Gemm g{HB, W13 + (size_t)2 * DFF * DM, DM, DM, SEQ, 2 * DFF, DM, 0}; StaticOrder S; S.init(SEQ, 2 * DFF, G, bid); EpiSwiglu E{BIG, DFF, RS + 5 * SEQ}; gemm_phase(lds, g, S, E); }
    SEAM(16);
    if (IN(17)) { Gemm g{BIG, W2 + (size_t)DM * DFF, DFF, DFF, SEQ, DM, DFF, 0, 1}; StaticOrder S; S.init(SEQ, DM, G, bid, 4); EpiResid<true, 6> E{RS}; gemm_phase(lds, g, S, E); }
    SEAM(17);
    if (IN(18)) final_norm_phase(HB, p.final_g, RS + 6 * SEQ, H, G, bid);
#undef IN
#undef SEAM
}

extern "C" void kernel_launch(void* const* d_in, const int* in_sizes, int n_in, void* d_out, int out_size, void* d_ws, size_t ws_size, hipStream_t stream) {
    static int grid = 0;
    if (grid == 0) {
        if (n_in != 14 || out_size != SEQ * DM || ws_size < WS_END) { fprintf(stderr, "kernel_launch: unexpected shapes (n_in %d, out %d, ws %zu, need %zu)\n", n_in, out_size, ws_size, (size_t)WS_END); grid = -1; return; }
        int dev = 0, cus = 0, per_cu = 0;
        hipGetDevice(&dev);
        hipDeviceGetAttribute(&cus, hipDeviceAttributeMultiprocessorCount, dev);
        if (hipFuncSetAttribute((const void*)mega_fwd, hipFuncAttributeMaxDynamicSharedMemorySize, LDS_BYTES) != hipSuccess) { fprintf(stderr, "kernel_launch: hipFuncSetAttribute failed\n"); grid = -1; return; }
        if (hipOccupancyMaxActiveBlocksPerMultiprocessor(&per_cu, (const void*)mega_fwd, NTHR, LDS_BYTES) != hipSuccess || per_cu < 1) { fprintf(stderr, "kernel_launch: occupancy query gave %d\n", per_cu); per_cu = 1; }
        (void)hipGetLastError();
        grid = cus * 1;
    }
    if (grid < 0) return;
    Params p{};
    p.x = (const float*)d_in[0]; p.pos = (const int*)d_in[1]; p.norm_g = (const float*)d_in[2]; p.w1 = (const float*)d_in[3]; p.w3 = (const float*)d_in[4]; p.w2 = (const float*)d_in[5];
    p.w_in = (const float*)d_in[6]; p.conv_w = (const float*)d_in[7]; p.pool_w = (const float*)d_in[8]; p.pool_scale = (const float*)d_in[9]; p.w_out = (const float*)d_in[10];
    p.w_qkv = (const float*)d_in[11]; p.w_o = (const float*)d_in[12]; p.final_g = (const float*)d_in[13];
    p.out = (float*)d_out; p.ws = (unsigned char*)d_ws;
    for (int i = 0; i < 16; ++i) p.inv.v[i] = (float)std::pow(500000.0, -(double)(2 * i) / 32.0);
#if MK_PER_PHASE
    for (int k = 0; k < NPHASE; ++k) {
        p.ph_lo = k; p.ph_hi = k + 1;
        hipLaunchKernelGGL(mega_fwd, dim3(grid), dim3(NTHR), LDS_BYTES, stream, p);
    }
#else
    p.ph_lo = 0; p.ph_hi = NPHASE;
    if (hipMemsetAsync((unsigned char*)d_ws + WS_BAR, 0, BAR_BYTES, stream) != hipSuccess) { fprintf(stderr, "kernel_launch: memset of barrier words failed\n"); return; }
    void* args[] = {&p};
    hipError_t e = hipLaunchCooperativeKernel((const void*)mega_fwd, dim3(grid), dim3(NTHR), args, LDS_BYTES, stream);
    if (e != hipSuccess) fprintf(stderr, "kernel_launch: cooperative launch failed: %s (grid %d)\n", hipGetErrorString(e), grid);
#endif
}
```

```cpp
#include <hip/hip_runtime.h>
#include <hip/hip_cooperative_groups.h>
#include <cstdio>
#include <cstdint>
#include <cmath>
namespace cg = cooperative_groups;

#ifndef MK_PER_PHASE
#define MK_PER_PHASE 0
#endif

#define LAS __attribute__((address_space(3)))
typedef unsigned short bf16_t;
typedef short bf16x8 __attribute__((ext_vector_type(8)));
typedef short s16x4 __attribute__((ext_vector_type(4)));
typedef float f32x4 __attribute__((ext_vector_type(4)));
typedef unsigned u32x4 __attribute__((ext_vector_type(4)));
typedef unsigned u32x2 __attribute__((ext_vector_type(2)));

constexpr int SEQ = 16384, DM = 2048, DFF = 5632, NHEAD = 16, HDIM = 128;
constexpr int NTHR = 512;
constexpr float RMS_EPS = 1e-6f;

constexpr size_t SZ_W13 = (size_t)2 * DFF * DM * 2;
constexpr size_t SZ_W2 = (size_t)DM * DFF * 2;
constexpr size_t WS_W13 = 0;
constexpr size_t WS_W2 = WS_W13 + 2 * SZ_W13;
constexpr size_t WS_WA = WS_W2 + 2 * SZ_W2;
constexpr size_t WS_WB = WS_WA + (size_t)6144 * DM * 2;
constexpr size_t WS_POOLW = WS_WB + (size_t)DM * DM * 2;
constexpr size_t WS_ROPE = WS_POOLW + (size_t)4 * 256 * 256 * 2;
constexpr size_t WS_XN = WS_ROPE + (size_t)SEQ * 32 * 4;
constexpr size_t WS_BIG = WS_XN + (size_t)SEQ * DM * 2;
constexpr size_t WS_OG = WS_BIG + (size_t)SEQ * 6144 * 2;
constexpr size_t WS_LSE = WS_OG + (size_t)3 * SEQ * DM * 2;
constexpr size_t WS_HB = WS_LSE + (size_t)3 * SEQ * 16 * 4;
constexpr size_t WS_RS = WS_HB + (size_t)SEQ * DM * 2;
constexpr size_t WS_BAR = WS_RS + (size_t)7 * SEQ * 4;
constexpr size_t BAR_BYTES = 3456 * 4;
constexpr size_t WS_END = WS_BAR + 16384;

constexpr int BM = 256, BK = 64, HALF = 128, HTB = HALF * BK * 2, STAGE_BYTES = 8 * HTB, NXCD = 8, WGM = 8;

__host__ __device__ __forceinline__ int lds_byte(int r, int c) { const int st = (r >> 4) * 2 + (c >> 5), rr = r & 15, cc = c & 31, ob = rr * 64 + cc * 2; return st * 1024 + (ob ^ (((ob >> 9) & 1) << 5)); }
__host__ __device__ __forceinline__ void stage_rc(int b, int& R, int& C) { const int st = b / 1024, sb = b % 1024, swz = sb ^ (((sb >> 9) & 1) << 5); R = (st >> 1) * 16 + swz / 64; C = (st & 1) * 32 + (swz % 64) / 2; }
__host__ __device__ __forceinline__ int perm32(int rho) { const int n = rho >> 4, i = rho & 15; return 8 * (i >> 2) + 4 * n + (i & 3); }

struct Unit { int pm, pn; };
struct Gemm { const bf16_t* A; const bf16_t* Bt; int lda, ldb, M, N, K; int a_pn_off; int rev0 = 0; };

struct StaticOrder {
    int nM, nN, nwg, G, c, wgm;
    __device__ void init(int M, int N, int G_, int c_, int wgm_ = WGM) { nM = M / BM; nN = N / BM; nwg = nM * nN; G = G_; c = c_; wgm = wgm_; }
    __device__ bool next(int i, Unit& u) const {
        const long L = (long)i * G + c; if (L >= nwg) return false;
        int wgid = (int)L; { const int q = nwg / NXCD, r = nwg % NXCD, xcd = wgid % NXCD, off = wgid / NXCD; wgid = (xcd < r ? xcd * (q + 1) : r * (q + 1) + (xcd - r) * q) + off; }
        const int nig = wgm * nN, gid = wgid / nig, fm = gid * wgm, gsz = (nM - fm) < wgm ? (nM - fm) : wgm;
        u.pm = fm + ((wgid % nig) % gsz); u.pn = (wgid % nig) / gsz; return true;
    }
};

__device__ __forceinline__ unsigned cvt_pk_bf16(float lo, float hi) { unsigned r; asm volatile("v_cvt_pk_bf16_f32 %0, %1, %2" : "=v"(r) : "v"(lo), "v"(hi)); return r; }
__device__ __forceinline__ float bf_lo(unsigned w) { return __uint_as_float(w << 16); }
__device__ __forceinline__ float bf_hi(unsigned w) { return __uint_as_float(w & 0xffff0000u); }
__device__ __forceinline__ float rs_to_r(float ss) { return __builtin_amdgcn_rsqf(ss * (1.0f / DM) + RMS_EPS); }
__device__ __forceinline__ float silu_f(float v) { return v * __builtin_amdgcn_rcpf(1.0f + __expf(-v)); }


struct EpiSwiglu {
    static constexpr bool PERM = true;
    bf16_t* O; int ldc; const float* rs;
    static constexpr bool HAS_RS = true;
    __device__ __forceinline__ void operator()(const f32x4 (&acc)[2][2][4][2], const Unit& u, int wr, int wc, int fr, int fq, const float (&rr)[2][4]) const {
        const int row0 = u.pm * BM + wr * 64 + fr, col0 = u.pn * HALF + wc * 32 + 8 * fq;
#pragma unroll
        for (int ai = 0; ai < 2; ++ai)
#pragma unroll
            for (int m = 0; m < 4; ++m) {
                const int row = row0 + ai * HALF + m * 16;
                bf16_t* rowp = O + (size_t)row * ldc + col0;
                const float r = rs_to_r(rr[ai][m]);
                const float nrl = -1.4426950408889634f * r, r2 = r * r;
                const f32x4 g0 = acc[ai][0][m][0], g1 = acc[ai][0][m][1], u0 = acc[ai][1][m][0], u1 = acc[ai][1][m][1];
                const f32x4 t0 = g0 * nrl, t1 = g1 * nrl;
                f32x4 e0, e1;
#pragma unroll
                for (int j = 0; j < 4; ++j) { e0[j] = __builtin_amdgcn_exp2f(t0[j]); e1[j] = __builtin_amdgcn_exp2f(t1[j]); }
                e0 = e0 + 1.0f; e1 = e1 + 1.0f;
#pragma unroll
                for (int j = 0; j < 4; ++j) { e0[j] = __builtin_amdgcn_rcpf(e0[j]); e1[j] = __builtin_amdgcn_rcpf(e1[j]); }
                const f32x4 v0 = (g0 * u0) * r2 * e0, v1 = (g1 * u1) * r2 * e1;
                u32x4 w; w.x = cvt_pk_bf16(v0[0], v0[1]); w.y = cvt_pk_bf16(v0[2], v0[3]); w.z = cvt_pk_bf16(v1[0], v1[1]); w.w = cvt_pk_bf16(v1[2], v1[3]);
                *(u32x4*)rowp = w;
            }
    }
};
struct EpiBf16 {
    static constexpr bool PERM = true;
    bf16_t* O; int ldc; const float* scale; const float* rs;
    static constexpr bool HAS_RS = true;
    __device__ __forceinline__ void operator()(const f32x4 (&acc)[2][2][4][2], const Unit& u, int wr, int wc, int fr, int fq, const float (&rr)[2][4]) const {
        const int row0 = u.pm * BM + wr * 64 + fr, col0 = u.pn * BM + wc * 32 + 8 * fq;
        f32x4 sv[2][2];
#pragma unroll
        for (int bj = 0; bj < 2; ++bj)
#pragma unroll
            for (int n = 0; n < 2; ++n) sv[bj][n] = scale ? *(const f32x4*)(scale + col0 + bj * HALF + 4 * n) : (f32x4){1.f, 1.f, 1.f, 1.f};
#pragma unroll
        for (int ai = 0; ai < 2; ++ai)
#pragma unroll
            for (int m = 0; m < 4; ++m) {
                const int row = row0 + ai * HALF + m * 16;
                bf16_t* rowp = O + (size_t)row * ldc + col0;
                const float r = rs ? rs_to_r(rr[ai][m]) : 1.0f;
#pragma unroll
                for (int bj = 0; bj < 2; ++bj) {
                    const f32x4 v0 = acc[ai][bj][m][0] * sv[bj][0] * r, v1 = acc[ai][bj][m][1] * sv[bj][1] * r;
                    u32x4 w; w.x = cvt_pk_bf16(v0[0], v0[1]); w.y = cvt_pk_bf16(v0[2], v0[3]); w.z = cvt_pk_bf16(v1[0], v1[1]); w.w = cvt_pk_bf16(v1[2], v1[3]);
                    *(u32x4*)(rowp + bj * HALF) = w;
                }
            }
    }
};
template <bool HALFA, int SLOT> struct EpiResid {
    static constexpr bool PERM = true;
    float* rsbase;
    static constexpr bool HAS_RS = false; const float* rs = nullptr;
    __device__ __forceinline__ void operator()(const f32x4 (&acc)[2][2][4][2], const Unit& u, int wr, int wc, int fr, int fq, const float (&)[2][4]) const {
        const int row0 = u.pm * BM + wr * 64 + fr, col0 = u.pn * BM + wc * 32 + 8 * fq;
        constexpr int ldc = DM; constexpr float alpha = HALFA ? 0.5f : 1.0f;
        float* rs = rsbase + (size_t)SLOT * SEQ;
        bf16_t* hb = (bf16_t*)((unsigned char*)rsbase - (size_t)SEQ * DM * 2);
        float ssv[2][4];
#pragma unroll
        for (int ai = 0; ai < 2; ++ai) {
            u32x4 b[4][2];
#pragma unroll
            for (int m = 0; m < 4; ++m)
#pragma unroll
                for (int bj = 0; bj < 2; ++bj) b[m][bj] = *(const u32x4*)(hb + (size_t)(row0 + ai * HALF + m * 16) * ldc + col0 + bj * HALF);
            __builtin_amdgcn_sched_barrier(0);
#pragma unroll
            for (int m = 0; m < 4; ++m) {
                const size_t off = (size_t)(row0 + ai * HALF + m * 16) * ldc + col0;
                float ss = 0.f;
#pragma unroll
                for (int bj = 0; bj < 2; ++bj) {
                    const f32x4 b0 = (f32x4){bf_lo(b[m][bj].x), bf_hi(b[m][bj].x), bf_lo(b[m][bj].y), bf_hi(b[m][bj].y)};
                    const f32x4 b1 = (f32x4){bf_lo(b[m][bj].z), bf_hi(b[m][bj].z), bf_lo(b[m][bj].w), bf_hi(b[m][bj].w)};
                    const f32x4 v0 = b0 + alpha * acc[ai][bj][m][0], v1 = b1 + alpha * acc[ai][bj][m][1];
                    ss += (v0[0] * v0[0] + v0[1] * v0[1]) + (v0[2] * v0[2] + v0[3] * v0[3]) + (v1[0] * v1[0] + v1[1] * v1[1]) + (v1[2] * v1[2] + v1[3] * v1[3]);
                    u32x4 w; w.x = cvt_pk_bf16(v0[0], v0[1]); w.y = cvt_pk_bf16(v0[2], v0[3]); w.z = cvt_pk_bf16(v1[0], v1[1]); w.w = cvt_pk_bf16(v1[2], v1[3]);
                    *(u32x4*)(hb + off + bj * HALF) = w;
                }
                ssv[ai][m] = ss;
            }
            __builtin_amdgcn_sched_barrier(0);
        }
#pragma unroll
        for (int ai = 0; ai < 2; ++ai)
#pragma unroll
            for (int m = 0; m < 4; ++m) {
                float ss = ssv[ai][m];
                ss += __shfl_xor(ss, 16); ss += __shfl_xor(ss, 32);
                if (fq == 0) (void)__hip_atomic_fetch_add(rs + row0 + ai * HALF + m * 16, ss, __ATOMIC_RELAXED, __HIP_MEMORY_SCOPE_AGENT);
            }
    }
};
struct EpiQkv {
    static constexpr bool PERM = true;
    bf16_t* O; int ldc; const float* rope; const float* rs;
    static constexpr bool HAS_RS = true;
    __device__ __forceinline__ void operator()(const f32x4 (&acc)[2][2][4][2], const Unit& u, int wr, int wc, int fr, int fq, const float (&rr)[2][4]) const {
        const int row0 = u.pm * BM + wr * 64 + fr, col0 = u.pn * BM + wc * 32 + 8 * fq;
        const bool rot = (wc == 0) && (u.pn < 16);
        f32x4 csa[2][4], sna[2][4];
#pragma unroll
        for (int ai = 0; ai < 2; ++ai)
#pragma unroll
            for (int m = 0; m < 4; ++m) {
                const int row = row0 + ai * HALF + m * 16;
                csa[ai][m] = (f32x4){1.f, 1.f, 1.f, 1.f}; sna[ai][m] = (f32x4){0.f, 0.f, 0.f, 0.f};
                if (rot) { csa[ai][m] = *(const f32x4*)(rope + (size_t)row * 32 + 4 * fq); sna[ai][m] = *(const f32x4*)(rope + (size_t)row * 32 + 16 + 4 * fq); }
            }
        __builtin_amdgcn_sched_barrier(0);
#pragma unroll
        for (int ai = 0; ai < 2; ++ai) {
#pragma unroll
            for (int m = 0; m < 4; ++m) {
                const int row = row0 + ai * HALF + m * 16;
                bf16_t* rowp = O + (size_t)row * ldc + col0;
                const float r = rs_to_r(rr[ai][m]);
                const f32x4 cs = csa[ai][m], sn = sna[ai][m];
#pragma unroll
                for (int bj = 0; bj < 2; ++bj) {
                    const f32x4 x1 = acc[ai][bj][m][0] * r, x2 = acc[ai][bj][m][1] * r;
                    const f32x4 r1 = x1 * cs - x2 * sn, r2 = x2 * cs + x1 * sn;
                    u32x4 w; w.x = cvt_pk_bf16(r1[0], r1[1]); w.y = cvt_pk_bf16(r1[2], r1[3]); w.z = cvt_pk_bf16(r2[0], r2[1]); w.w = cvt_pk_bf16(r2[2], r2[3]);
                    *(u32x4*)(rowp + bj * HALF) = w;
                }
            }
            __builtin_amdgcn_sched_barrier(0);
        }
    }
};

template <class Epi>
__device__ __forceinline__ void gemm_phase(LAS unsigned char* lds, const Gemm g, const StaticOrder S, const Epi E) {
    const int tid = threadIdx.x, wid = __builtin_amdgcn_readfirstlane(tid >> 6), lane = tid & 63, wr = wid >> 2, wc = wid & 3, fr = lane & 15, fq = lane >> 4;
    const int K = g.K, nt = K / BK;
    unsigned voffA[2], voffB[2];
#pragma unroll
    for (int i = 0; i < 2; ++i) { int R, C; stage_rc(tid * 16 + i * 8192, R, C); const int Rb = Epi::PERM ? ((R & ~31) + perm32(R & 31)) : R;
        voffA[i] = (unsigned)(R * g.lda + C) * 2u; voffB[i] = (unsigned)(Rb * g.ldb + C) * 2u; }
    const size_t kstep = (size_t)(BK * 2);
    const size_t hstepA = (size_t)HALF * g.lda * 2, hstepB = (size_t)HALF * g.ldb * 2;
    const size_t tstepA = 2 * hstepA, tstepB = 2 * hstepB;
    const unsigned ldsw = (unsigned)wid * 1024u;
    const int aoff = lds_byte(wr * 64 + fr, fq * 8), boff = lds_byte(wc * 32 + fr, fq * 8);
#define PG8_SA(b, h) (((b) * 2 + (h)) * HTB)
#define PG8_SB(b, h) ((4 + (b) * 2 + (h)) * HTB)
#define PG8_STAGE(bufoff, gbase, voff) do { _Pragma("unroll") for (int _i = 0; _i < 2; ++_i) \
        __builtin_amdgcn_global_load_lds((const unsigned*)((const char*)(gbase) + (voff)[_i]), (LAS unsigned*)(lds + (bufoff) + ldsw + _i * 8192), 16, 0, 0); } while (0)
#define PG8_LDA(dst, b, h) do { _Pragma("unroll") for (int m = 0; m < 4; ++m) _Pragma("unroll") for (int k = 0; k < 2; ++k) dst[m][k] = *(const LAS bf16x8*)(lds + PG8_SA(b, h) + aoff + m * 2048 + k * 1024); } while (0)
#define PG8_LDB(dst, b, h) do { _Pragma("unroll") for (int n = 0; n < 2; ++n) _Pragma("unroll") for (int k = 0; k < 2; ++k) dst[n][k] = *(const LAS bf16x8*)(lds + PG8_SB(b, h) + boff + n * 2048 + k * 1024); } while (0)
#define PG8_MMA(ai, bj, At, Bt) do { __builtin_amdgcn_s_setprio(1); _Pragma("unroll") for (int m = 0; m < 4; ++m) _Pragma("unroll") for (int n = 0; n < 2; ++n) _Pragma("unroll") for (int k = 0; k < 2; ++k) \
        acc[ai][bj][m][n] = __builtin_amdgcn_mfma_f32_16x16x32_bf16(Bt[n][k], At[m][k], acc[ai][bj][m][n], 0, 0, 0); __builtin_amdgcn_s_setprio(0); } while (0)
#define PG8_WAIT_V(n) asm volatile("s_waitcnt vmcnt(" #n ")" ::: "memory")
#define PG8_WAIT_L(n) asm volatile("s_waitcnt lgkmcnt(" #n ")" ::: "memory")
#define PG8_BAR __builtin_amdgcn_s_barrier()
#define PG8_SCHED __builtin_amdgcn_sched_barrier(0)
    Unit cur, nxt; int ui = 0;
    if (!S.next(0, cur)) return;
    f32x4 acc[2][2][4][2];
#pragma unroll
    for (int a = 0; a < 2; ++a)
#pragma unroll
        for (int b = 0; b < 2; ++b)
#pragma unroll
            for (int m = 0; m < 4; ++m)
#pragma unroll
                for (int n = 0; n < 2; ++n) acc[a][b][m][n] = (f32x4){0.f, 0.f, 0.f, 0.f};
    bf16x8 At[4][2], B0[2][2], B1[2][2];
    float rrc[2][4]; int rr_pm = -1;
#pragma unroll
    for (int a = 0; a < 2; ++a)
#pragma unroll
        for (int m = 0; m < 4; ++m) rrc[a][m] = 0.f;
    const long klast = (long)(nt - 1) * (long)kstep;
    long ksc = g.rev0 ? -(long)kstep : (long)kstep, ksn = ksc;
    const char* cA = (const char*)g.A + (size_t)cur.pm * tstepA + (size_t)cur.pn * g.a_pn_off + (g.rev0 ? klast : 0); const char* cB = (const char*)g.Bt + (size_t)cur.pn * tstepB + (g.rev0 ? klast : 0);
    PG8_STAGE(PG8_SB(0, 0), cB, voffB); PG8_STAGE(PG8_SB(0, 1), cB + hstepB, voffB); PG8_STAGE(PG8_SA(0, 0), cA, voffA); PG8_STAGE(PG8_SA(0, 1), cA + hstepA, voffA);
    if (wr == 1) PG8_BAR;
    PG8_WAIT_V(2); PG8_BAR;
    PG8_STAGE(PG8_SB(1, 0), cB + ksc, voffB); PG8_STAGE(PG8_SA(1, 0), cA + ksc, voffA); PG8_STAGE(PG8_SB(1, 1), cB + hstepB + ksc, voffB);
    PG8_WAIT_V(6); PG8_BAR;
    for (;;) {
        const bool has_next = S.next(ui + 1, nxt);
        const bool nrev = has_next && ((ui + 1 + g.rev0) & 1);
        ksn = has_next ? (nrev ? -(long)kstep : (long)kstep) : ksc;
        const char* nA = has_next ? (const char*)g.A + (size_t)nxt.pm * tstepA + (size_t)nxt.pn * g.a_pn_off + (nrev ? klast : 0) : cA;
        const char* nB = has_next ? (const char*)g.Bt + (size_t)nxt.pn * tstepB + (nrev ? klast : 0) : cB;
        for (int t = 0; t < nt; t += 2) {
            const bool last = (t == nt - 2);
            const char* a1 = cA + (long)(t + 1) * ksc;
            const char* a2 = last ? nA : cA + (long)(t + 2) * ksc; const char* b2 = last ? nB : cB + (long)(t + 2) * ksc;
            const long ks3 = last ? ksn : ksc;
            const char* a3 = a2 + ks3; const char* b3 = b2 + ks3;
            PG8_LDB(B0, 0, 0); PG8_LDB(B1, 0, 1); PG8_SCHED; PG8_LDA(At, 0, 0); PG8_STAGE(PG8_SA(1, 1), a1 + hstepA, voffA);
            PG8_WAIT_V(8); PG8_WAIT_L(0); PG8_BAR; PG8_MMA(0, 0, At, B0); PG8_MMA(0, 1, At, B1); PG8_BAR; PG8_SCHED;
            PG8_LDA(At, 0, 1); PG8_STAGE(PG8_SB(0, 0), b2, voffB); PG8_STAGE(PG8_SB(0, 1), b2 + hstepB, voffB); PG8_STAGE(PG8_SA(0, 0), a2, voffA);
            PG8_WAIT_V(8); PG8_WAIT_L(0); PG8_BAR; PG8_MMA(1, 0, At, B0); PG8_MMA(1, 1, At, B1); PG8_BAR; PG8_SCHED;
            PG8_LDB(B0, 1, 0); PG8_LDB(B1, 1, 1); PG8_SCHED; PG8_LDA(At, 1, 0); PG8_STAGE(PG8_SA(0, 1), a2 + hstepA, voffA);
            PG8_WAIT_V(8); PG8_WAIT_L(0); PG8_BAR; PG8_MMA(0, 0, At, B0); PG8_MMA(0, 1, At, B1); PG8_BAR; PG8_SCHED;
            PG8_LDA(At, 1, 1); PG8_STAGE(PG8_SB(1, 0), b3, voffB); PG8_STAGE(PG8_SB(1, 1), b3 + hstepB, voffB); PG8_STAGE(PG8_SA(1, 0), a3, voffA);
            PG8_WAIT_V(8); PG8_WAIT_L(0); PG8_BAR; PG8_MMA(1, 0, At, B0); PG8_MMA(1, 1, At, B1); PG8_BAR; PG8_SCHED;
        }
        if (wr == 0) PG8_BAR;
        if (Epi::HAS_RS && E.rs && cur.pm != rr_pm) {
            const int rrow0 = cur.pm * BM + wr * 64 + fr;
#pragma unroll
            for (int ai = 0; ai < 2; ++ai)
#pragma unroll
                for (int m = 0; m < 4; ++m) rrc[ai][m] = E.rs[rrow0 + ai * HALF + m * 16];
            rr_pm = cur.pm;
        }
        E(acc, cur, wr, wc, fr, fq, rrc);
        if (!has_next) break;
#pragma unroll
        for (int a = 0; a < 2; ++a)
#pragma unroll
            for (int b = 0; b < 2; ++b)
#pragma unroll
                for (int m = 0; m < 4; ++m)
#pragma unroll
                    for (int n = 0; n < 2; ++n) acc[a][b][m][n] = (f32x4){0.f, 0.f, 0.f, 0.f};
        cur = nxt; cA = nA; cB = nB; ksc = ksn; ++ui;
        if (wr == 1) PG8_BAR;
    }
    PG8_WAIT_V(0);
    PG8_BAR;
#undef PG8_SA
#undef PG8_SB
#undef PG8_STAGE
#undef PG8_LDA
#undef PG8_LDB
#undef PG8_MMA
#undef PG8_WAIT_V
#undef PG8_WAIT_L
#undef PG8_BAR
#undef PG8_SCHED
}

__device__ __forceinline__ void convert_w(LAS float* tile, const float* __restrict__ src, int K, int N, bf16_t* __restrict__ dst, int mode, int sidx, const float* __restrict__ gk, int G, int bid) {
    const int tid = threadIdx.x;
    const int tk = K / 64, tn = N / 64, ntile = tk * tn;
    const int kk = tid >> 4, n4 = (tid & 15) * 4;
    f32x4 pv[2];
    if (bid < ntile) {
        const int k0 = (bid % tk) * 64, n0 = (bid / tk) * 64;
#pragma unroll
        for (int i = 0; i < 2; ++i) pv[i] = __builtin_nontemporal_load((const f32x4*)(src + (size_t)(k0 + kk + 32 * i) * N + n0 + n4));
    }
    for (int t = bid; t < ntile; t += G) {
        const int k0 = (t % tk) * 64, n0 = (t / tk) * 64;
#pragma unroll
        for (int i = 0; i < 2; ++i) {
            const int k = kk + 32 * i;
            tile[k * 65 + n4 + 0] = pv[i][0]; tile[k * 65 + n4 + 1] = pv[i][1]; tile[k * 65 + n4 + 2] = pv[i][2]; tile[k * 65 + n4 + 3] = pv[i][3];
        }
        __syncthreads();
        if (t + G < ntile) {
            const int k1 = ((t + G) % tk) * 64, n1 = ((t + G) / tk) * 64;
#pragma unroll
            for (int i = 0; i < 2; ++i) pv[i] = __builtin_nontemporal_load((const f32x4*)(src + (size_t)(k1 + kk + 32 * i) * N + n1 + n4));
        }
        const int n = tid >> 3, k8 = (tid & 7) * 8;
        float f[8];
#pragma unroll
        for (int j = 0; j < 8; ++j) f[j] = tile[(k8 + j) * 65 + n];
        if (gk) {
            const f32x4 ga = *(const f32x4*)(gk + k0 + k8), gb = *(const f32x4*)(gk + k0 + k8 + 4);
            f[0] *= ga[0]; f[1] *= ga[1]; f[2] *= ga[2]; f[3] *= ga[3]; f[4] *= gb[0]; f[5] *= gb[1]; f[6] *= gb[2]; f[7] *= gb[3];
        }
        u32x4 w; w.x = cvt_pk_bf16(f[0], f[1]); w.y = cvt_pk_bf16(f[2], f[3]); w.z = cvt_pk_bf16(f[4], f[5]); w.w = cvt_pk_bf16(f[6], f[7]);
        const int nn = n0 + n;
        int row = nn;
        if (mode == 1) row = 256 * (nn >> 7) + 128 * sidx + (nn & 127);
        if (mode == 2 && nn < 4096 && (nn & 127) < 32) { const int d = nn & 31; row = (nn & ~31) + 8 * ((d >> 2) & 3) + 4 * (d >> 4) + (d & 3); }
        *(u32x4*)(dst + (size_t)row * K + k0 + k8) = w;
        __syncthreads();
    }
}

__device__ __forceinline__ float wave_sum(float v) {
#pragma unroll
    for (int o = 32; o >= 1; o >>= 1) v += __shfl_xor(v, o);
    return v;
}

__device__ __forceinline__ void cast_phase(const float* src, bf16_t* hb, float* rs, int G, int bid) {
    const int wave = threadIdx.x >> 6, lane = threadIdx.x & 63;
    for (int i = bid * NTHR + threadIdx.x; i < 6 * SEQ; i += G * NTHR) rs[SEQ + i] = 0.f;
    for (int row = bid * 8 + wave; row < SEQ; row += G * 8) {
        const float* p = src + (size_t)row * DM + lane * 8;
        f32x4 v[8];
#pragma unroll
        for (int i = 0; i < 4; ++i) { v[2 * i] = __builtin_nontemporal_load((const f32x4*)(p + i * 512)); v[2 * i + 1] = __builtin_nontemporal_load((const f32x4*)(p + i * 512 + 4)); }
        float ss = 0.f;
#pragma unroll
        for (int i = 0; i < 8; ++i) ss += v[i][0] * v[i][0] + v[i][1] * v[i][1] + v[i][2] * v[i][2] + v[i][3] * v[i][3];
        ss = wave_sum(ss);
        if (lane == 0) rs[row] = ss;
#pragma unroll
        for (int i = 0; i < 4; ++i) {
            const f32x4 a = v[2 * i], b = v[2 * i + 1];
            u32x4 w; w.x = cvt_pk_bf16(a[0], a[1]); w.y = cvt_pk_bf16(a[2], a[3]); w.z = cvt_pk_bf16(b[0], b[1]); w.w = cvt_pk_bf16(b[2], b[3]);
            *(u32x4*)(hb + (size_t)row * DM + i * 512 + lane * 8) = w;
        }
    }
}
__device__ __forceinline__ void final_norm_phase(const bf16_t* __restrict__ hb, const float* __restrict__ g, const float* __restrict__ rs, float* __restrict__ dst, int G, int bid) {
    const int wave = threadIdx.x >> 6, lane = threadIdx.x & 63;
    for (int row = bid * 8 + wave; row < SEQ; row += G * 8) {
        const bf16_t* p = hb + (size_t)row * DM + lane * 8;
        u32x4 v[4];
#pragma unroll
        for (int i = 0; i < 4; ++i) v[i] = *(const u32x4*)(p + i * 512);
        const float r = rs_to_r(rs[row]);
        float* q = dst + (size_t)row * DM + lane * 8;
#pragma unroll
        for (int i = 0; i < 4; ++i) {
            const f32x4 g0 = *(const f32x4*)(g + i * 512 + lane * 8), g1 = *(const f32x4*)(g + i * 512 + lane * 8 + 4);
            const f32x4 a = (f32x4){bf_lo(v[i].x), bf_hi(v[i].x), bf_lo(v[i].y), bf_hi(v[i].y)}, b = (f32x4){bf_lo(v[i].z), bf_hi(v[i].z), bf_lo(v[i].w), bf_hi(v[i].w)};
            *(f32x4*)(q + i * 512) = a * r * g0; *(f32x4*)(q + i * 512 + 4) = b * r * g1;
        }
    }
}

struct InvFreq { float v[16]; };
__device__ __forceinline__ void rope_phase(const int* pos, const InvFreq& inv, float* rope, int G, int bid) {
    for (int idx = bid * NTHR + threadIdx.x; idx < SEQ * 16; idx += G * NTHR) {
        const int t = idx >> 4, i = idx & 15;
        float fv = inv.v[0];
#pragma unroll
        for (int j = 1; j < 16; ++j) fv = (i == j) ? inv.v[j] : fv;
        const float ang = (float)pos[t] * fv;
        const double rev = (double)ang * 0.15915494309189533577;
        const float fr = (float)(rev - rint(rev));
        rope[(size_t)t * 32 + i] = __builtin_amdgcn_cosf(fr);
        rope[(size_t)t * 32 + 16 + i] = __builtin_amdgcn_sinf(fr);
    }
}

__device__ __forceinline__ void convpool_phase(const bf16_t* __restrict__ z, const float* __restrict__ conv_w, bf16_t* __restrict__ ycat, bf16_t* __restrict__ pooled, int G, int bid) {
#pragma unroll 2
    for (int idx = bid * NTHR + threadIdx.x; idx < SEQ * 128; idx += G * NTHR) {
        const int t = idx >> 7, c0 = (idx & 127) * 8;
        u32x4 gc[3], hv[3];
#pragma unroll
        for (int j = 0; j < 3; ++j) {
            const int tt = t - 2 + j, tc = tt < 0 ? 0 : tt;
            gc[j] = *(const u32x4*)(z + (size_t)tc * 4096 + 1024 + c0); hv[j] = *(const u32x4*)(z + (size_t)tc * 4096 + 2048 + c0);
        }
        const u32x4 gb = *(const u32x4*)(z + (size_t)t * 4096 + c0);
        float a[8];
#pragma unroll
        for (int e = 0; e < 8; ++e) a[e] = 0.f;
#pragma unroll
        for (int j = 0; j < 3; ++j) {
            const float wm = (t - 2 + j) >= 0 ? 1.f : 0.f;
            const f32x4 w0 = *(const f32x4*)(conv_w + j * 1024 + c0) * wm, w1 = *(const f32x4*)(conv_w + j * 1024 + c0 + 4) * wm;
            a[0] += w0[0] * (bf_lo(gc[j].x) * bf_lo(hv[j].x)); a[1] += w0[1] * (bf_hi(gc[j].x) * bf_hi(hv[j].x));
            a[2] += w0[2] * (bf_lo(gc[j].y) * bf_lo(hv[j].y)); a[3] += w0[3] * (bf_hi(gc[j].y) * bf_hi(hv[j].y));
            a[4] += w1[0] * (bf_lo(gc[j].z) * bf_lo(hv[j].z)); a[5] += w1[1] * (bf_hi(gc[j].z) * bf_hi(hv[j].z));
            a[6] += w1[2] * (bf_lo(gc[j].w) * bf_lo(hv[j].w)); a[7] += w1[3] * (bf_hi(gc[j].w) * bf_hi(hv[j].w));
        }
        u32x4 w;
        w.x = cvt_pk_bf16(bf_lo(gb.x) * a[0], bf_hi(gb.x) * a[1]); w.y = cvt_pk_bf16(bf_lo(gb.y) * a[2], bf_hi(gb.y) * a[3]);
        w.z = cvt_pk_bf16(bf_lo(gb.z) * a[4], bf_hi(gb.z) * a[5]); w.w = cvt_pk_bf16(bf_lo(gb.w) * a[6], bf_hi(gb.w) * a[7]);
        *(u32x4*)(ycat + (size_t)t * DM + c0) = w;
    }
    for (int idx = bid * NTHR + threadIdx.x; idx < (SEQ / 4) * 128; idx += G * NTHR) {
        const int t0 = (idx >> 7) * 4, c0 = (idx & 127) * 8, win = 2 << (c0 >> 8);
        u32x4 uv[19];
#pragma unroll
        for (int i = 0; i < 19; ++i) { const int row = t0 - 15 + i, rc = row < 0 ? 0 : row; uv[i] = *(const u32x4*)(z + (size_t)rc * 4096 + 3072 + c0); }
        float a[4][8];
#pragma unroll
        for (int k = 0; k < 4; ++k)
#pragma unroll
            for (int e = 0; e < 8; ++e) a[k][e] = 0.f;
#pragma unroll
        for (int i = 0; i < 19; ++i) {
            const int d = i - 15;
            const float x0 = bf_lo(uv[i].x), x1 = bf_hi(uv[i].x), x2 = bf_lo(uv[i].y), x3 = bf_hi(uv[i].y), x4 = bf_lo(uv[i].z), x5 = bf_hi(uv[i].z), x6 = bf_lo(uv[i].w), x7 = bf_hi(uv[i].w);
#pragma unroll
            for (int k = 0; k < 4; ++k) {
                if (d <= k) {
                    const float mk = (d >= k - win + 1 && t0 + d >= 0) ? 1.f : 0.f;
                    a[k][0] += mk * x0; a[k][1] += mk * x1; a[k][2] += mk * x2; a[k][3] += mk * x3; a[k][4] += mk * x4; a[k][5] += mk * x5; a[k][6] += mk * x6; a[k][7] += mk * x7;
                }
            }
        }
#pragma unroll
        for (int k = 0; k < 4; ++k) {
            const int t = t0 + k, n = (t + 1) < win ? (t + 1) : win;
            const float rn = 1.0f / (float)n;
            const u32x4 u0 = uv[15 + k];
            u32x4 w;
            w.x = cvt_pk_bf16(a[k][0] * rn - bf_lo(u0.x), a[k][1] * rn - bf_hi(u0.x)); w.y = cvt_pk_bf16(a[k][2] * rn - bf_lo(u0.y), a[k][3] * rn - bf_hi(u0.y));
            w.z = cvt_pk_bf16(a[k][4] * rn - bf_lo(u0.z), a[k][5] * rn - bf_hi(u0.z)); w.w = cvt_pk_bf16(a[k][6] * rn - bf_lo(u0.w), a[k][7] * rn - bf_hi(u0.w));
            *(u32x4*)(pooled + (size_t)t * 1024 + c0) = w;
        }
    }
}

constexpr int KP = 272;
constexpr int ATT_LDS = 2 * 256 * KP;
__device__ __forceinline__ void attn_phase(LAS unsigned char* lds, const bf16_t* qkv, bf16_t* og, float* lse, int G, int bid) {
    const int tid = threadIdx.x, wid = __builtin_amdgcn_readfirstlane(tid >> 6), lane = tid & 63, fr = lane & 15, fq = lane >> 4;
    LAS unsigned char* Ks = lds; LAS unsigned char* Vs = lds + 256 * KP;
    const float sl2 = 0.08838834764831845f * 1.4426950408889634f;
    const int srow = tid >> 4, sch = tid & 15;
    constexpr int NSEG = 3 * 16 * 16, SEGLEN = 8;
    for (int seg = bid; seg < NSEG; seg += G) {
        const int h8 = seg & 7, tq = seg >> 3, sidx = tq & 15, uq = tq >> 4, gb = uq % 3, h = (uq / 3) * 8 + h8;
        const int sh = 2 * gb, dil = 1 << sh, r = sidx & (dil - 1), blk0 = (sidx >> sh) * SEGLEN;
        const bf16_t* kbase = qkv + 2048 + h * 128 + sch * 8;
        u32x4 rk[4], rv[4]; bf16x8 rq[4];
        __syncthreads();
        {
            u32x4 pk2[4], pv2[4];
            if (blk0 > 0) {
#pragma unroll
                for (int i = 0; i < 4; ++i) { const int c = srow + 32 * i; const size_t pos = (size_t)(((blk0 - 1) * 128 + c) * dil + r);
                    pk2[i] = *(const u32x4*)(kbase + pos * 6144); pv2[i] = *(const u32x4*)(kbase + pos * 6144 + 2048); }
            }
#pragma unroll
            for (int i = 0; i < 4; ++i) { const int c = srow + 32 * i; const size_t pos = (size_t)((blk0 * 128 + c) * dil + r);
                rk[i] = *(const u32x4*)(kbase + pos * 6144); rv[i] = *(const u32x4*)(kbase + pos * 6144 + 2048); }
            if (blk0 > 0) {
#pragma unroll
                for (int i = 0; i < 4; ++i) { const int c = srow + 32 * i; *(LAS u32x4*)(Ks + (128 + c) * KP + sch * 16) = pk2[i]; *(LAS u32x4*)(Vs + (128 + c) * KP + sch * 16) = pv2[i]; }
            }
#pragma unroll
            for (int i = 0; i < 4; ++i) { const int c = srow + 32 * i; *(LAS u32x4*)(Ks + c * KP + sch * 16) = rk[i]; *(LAS u32x4*)(Vs + c * KP + sch * 16) = rv[i]; }
        }
        {
            const size_t posq0 = (size_t)((blk0 * 128 + wid * 16 + fr) * dil + r);
#pragma unroll
            for (int kk = 0; kk < 4; ++kk) rq[kk] = *(const bf16x8*)(qkv + posq0 * 6144 + h * 128 + kk * 32 + fq * 8);
        }
        for (int j = 0; j < SEGLEN; ++j) {
            const int blk = blk0 + j, cs = j & 1, ps = cs ^ 1;
            bf16x8 Q[4];
#pragma unroll
            for (int kk = 0; kk < 4; ++kk) Q[kk] = rq[kk];
            __syncthreads();
            if (j + 1 < SEGLEN) {
#pragma unroll
                for (int i = 0; i < 4; ++i) { const int c = srow + 32 * i; const size_t pos = (size_t)(((blk + 1) * 128 + c) * dil + r);
                    rk[i] = *(const u32x4*)(kbase + pos * 6144); rv[i] = *(const u32x4*)(kbase + pos * 6144 + 2048); }
                const size_t posqn = (size_t)(((blk + 1) * 128 + wid * 16 + fr) * dil + r);
#pragma unroll
                for (int kk = 0; kk < 4; ++kk) rq[kk] = *(const bf16x8*)(qkv + posqn * 6144 + h * 128 + kk * 32 + fq * 8);
            }
            const int a = wid * 16 + fr;
            const size_t posq = (size_t)((blk * 128 + a) * dil + r);
            LAS unsigned char* Kp = Ks + ps * 128 * KP; LAS unsigned char* Kc = Ks + cs * 128 * KP;
            LAS unsigned char* Vp = Vs + ps * 128 * KP; LAS unsigned char* Vc = Vs + cs * 128 * KP;
            f32x4 sc[16];
#pragma unroll
            for (int s = 0; s < 16; ++s) {
                sc[s] = (f32x4){0.f, 0.f, 0.f, 0.f};
                if (s >= wid && s <= wid + 8 && (s >= 8 || blk > 0)) {
                    LAS unsigned char* kb = (s < 8 ? Kp : Kc) + (16 * (s & 7) + fr) * KP + 16 * fq;
#pragma unroll
                    for (int kk = 0; kk < 4; ++kk) {
                        const bf16x8 kf = *(const LAS bf16x8*)(kb + 64 * kk);
                        sc[s] = __builtin_amdgcn_mfma_f32_16x16x32_bf16(kf, Q[kk], sc[s], 0, 0, 0);
                    }
                }
            }
            float mx = -3.0e38f;
#pragma unroll
            for (int s = 0; s < 16; ++s) {
                if (s >= wid && s <= wid + 8 && (s >= 8 || blk > 0)) {
#pragma unroll
                    for (int jj = 0; jj < 4; ++jj) {
                        const int c = 16 * s + 4 * fq + jj;
                        const bool valid = (s < 8) ? (c >= a) : (c - 128 <= a);
                        const float v = valid ? sc[s][jj] * sl2 : -1.0e30f;
                        sc[s][jj] = v; mx = fmaxf(mx, v);
                    }
                }
            }
            mx = fmaxf(mx, __shfl_xor(mx, 16)); mx = fmaxf(mx, __shfl_xor(mx, 32));
            float l = 0.f;
#pragma unroll
            for (int s = 0; s < 16; ++s) {
                if (s >= wid && s <= wid + 8 && (s >= 8 || blk > 0)) {
#pragma unroll
                    for (int jj = 0; jj < 4; ++jj) { const float pp = __builtin_amdgcn_exp2f(sc[s][jj] - mx); sc[s][jj] = pp; l += pp; }
                } else sc[s] = (f32x4){0.f, 0.f, 0.f, 0.f};
            }
            l += __shfl_xor(l, 16); l += __shfl_xor(l, 32);
            f32x4 o[8];
#pragma unroll
            for (int dt = 0; dt < 8; ++dt) o[dt] = (f32x4){0.f, 0.f, 0.f, 0.f};
#pragma unroll
            for (int ks = 0; ks < 8; ++ks) {
                if (2 * ks + 1 >= wid && 2 * ks <= wid + 8 && (ks >= 4 || blk > 0)) {
                    union { u32x4 u; bf16x8 b; } P;
                    P.u.x = cvt_pk_bf16(sc[2 * ks][0], sc[2 * ks][1]); P.u.y = cvt_pk_bf16(sc[2 * ks][2], sc[2 * ks][3]);
                    P.u.z = cvt_pk_bf16(sc[2 * ks + 1][0], sc[2 * ks + 1][1]); P.u.w = cvt_pk_bf16(sc[2 * ks + 1][2], sc[2 * ks + 1][3]);
                    LAS unsigned char* vb = (ks < 4 ? Vp : Vc) + (32 * (ks & 3) + 4 * fq + (fr >> 2)) * KP + 8 * (fr & 3);
#pragma unroll
                    for (int dt = 0; dt < 8; ++dt) {
                        const s16x4 v0 = __builtin_amdgcn_ds_read_tr16_b64_v4i16((LAS s16x4*)(vb + 32 * dt));
                        const s16x4 v1 = __builtin_amdgcn_ds_read_tr16_b64_v4i16((LAS s16x4*)(vb + 16 * KP + 32 * dt));
                        const bf16x8 vf = __builtin_shufflevector(v0, v1, 0, 1, 2, 3, 4, 5, 6, 7);
                        o[dt] = __builtin_amdgcn_mfma_f32_16x16x32_bf16(vf, P.b, o[dt], 0, 0, 0);
                    }
                }
            }
            const float inv = 1.0f / l;
            bf16_t* op = og + (size_t)gb * SEQ * DM + posq * DM + h * 128 + ((fq & 1) ? 16 + 4 * (fq - 1) : 4 * fq);
#pragma unroll
            for (int dt = 0; dt < 8; dt += 2) {
                const unsigned ax = cvt_pk_bf16(o[dt][0] * inv, o[dt][1] * inv), ay = cvt_pk_bf16(o[dt][2] * inv, o[dt][3] * inv);
                const unsigned bx = cvt_pk_bf16(o[dt + 1][0] * inv, o[dt + 1][1] * inv), by = cvt_pk_bf16(o[dt + 1][2] * inv, o[dt + 1][3] * inv);
                const auto sx = __builtin_amdgcn_permlane16_swap(ax, bx, false, false);
                const auto sy = __builtin_amdgcn_permlane16_swap(ay, by, false, false);
                u32x4 w; w.x = sx[0]; w.y = sy[0]; w.z = sx[1]; w.w = sy[1];
                *(u32x4*)(op + 16 * dt) = w;
            }
            if (fq == 0) lse[(size_t)gb * SEQ * 16 + posq * 16 + h] = mx * 0.6931471805599453f + __logf(l);
            if (j + 1 < SEGLEN) {
                __syncthreads();
#pragma unroll
                for (int i = 0; i < 4; ++i) { const int c = srow + 32 * i; *(LAS u32x4*)(Ks + (ps * 128 + c) * KP + sch * 16) = rk[i]; *(LAS u32x4*)(Vs + (ps * 128 + c) * KP + sch * 16) = rv[i]; }
            }
        }
    }
}

__device__ __forceinline__ void combine_phase(const bf16_t* __restrict__ og, const float* __restrict__ lse, bf16_t* __restrict__ dst, int G, int bid) {
#pragma unroll 4
    for (int idx = bid * NTHR + threadIdx.x; idx < SEQ * 256; idx += G * NTHR) {
        const int t = idx >> 8, oc = idx & 255, h = oc >> 4;
        const float l0 = lse[(size_t)t * 16 + h], l1 = lse[(size_t)SEQ * 16 + (size_t)t * 16 + h], l2 = lse[(size_t)2 * SEQ * 16 + (size_t)t * 16 + h];
        const float mx = fmaxf(l0, fmaxf(l1, l2));
        float w0 = __expf(l0 - mx), w1 = __expf(l1 - mx), w2 = __expf(l2 - mx);
        const float inv = 1.0f / (w0 + w1 + w2); w0 *= inv; w1 *= inv; w2 *= inv;
        const size_t off = (size_t)t * DM + oc * 8;
        const u32x4 a = *(const u32x4*)(og + off), b = *(const u32x4*)(og + (size_t)SEQ * DM + off), c = *(const u32x4*)(og + (size_t)2 * SEQ * DM + off);
        u32x4 w;
        w.x = cvt_pk_bf16(w0 * bf_lo(a.x) + w1 * bf_lo(b.x) + w2 * bf_lo(c.x), w0 * bf_hi(a.x) + w1 * bf_hi(b.x) + w2 * bf_hi(c.x));
        w.y = cvt_pk_bf16(w0 * bf_lo(a.y) + w1 * bf_lo(b.y) + w2 * bf_lo(c.y), w0 * bf_hi(a.y) + w1 * bf_hi(b.y) + w2 * bf_hi(c.y));
        w.z = cvt_pk_bf16(w0 * bf_lo(a.z) + w1 * bf_lo(b.z) + w2 * bf_lo(c.z), w0 * bf_hi(a.z) + w1 * bf_hi(b.z) + w2 * bf_hi(c.z));
        w.w = cvt_pk_bf16(w0 * bf_lo(a.w) + w1 * bf_lo(b.w) + w2 * bf_lo(c.w), w0 * bf_hi(a.w) + w1 * bf_hi(b.w) + w2 * bf_hi(c.w));
        *(u32x4*)(dst + off) = w;
    }
}


#define XB_TMO      128
#define XB_XCNT(j)  (256  + 64 * (j))
#define XB_XSUB(j)  (1280 + 64 * (j))
#define XB_XGEN(j)  (2304 + 64 * (j))
#define XB_TOP      3328
#define XB_TOPGEN   3392
#define XCD_BAR_WORDS 3456
#define XB_SPIN_CAP (1u << 22)
__device__ __forceinline__ unsigned xb_ld(unsigned* p)              { return __hip_atomic_load(p, __ATOMIC_RELAXED, __HIP_MEMORY_SCOPE_AGENT); }
__device__ __forceinline__ unsigned xb_add(unsigned* p, unsigned v) { return __hip_atomic_fetch_add(p, v, __ATOMIC_RELAXED, __HIP_MEMORY_SCOPE_AGENT); }
__device__ __forceinline__ unsigned xb_xcc_id() { return (unsigned)__builtin_amdgcn_s_getreg((3 << 11) | 20) & 0xFu; }
#define XB_SPIN(cond, bar) do { unsigned _sp = 0; while (cond) { __builtin_amdgcn_s_sleep(1); \
    if ((++_sp & 255u) == 0u) { if (xb_ld(&(bar)[XB_TMO])) break; if (_sp > XB_SPIN_CAP) { atomicAdd(&(bar)[XB_TMO], 1u); break; } } } } while (0)
struct XcdBarrier { unsigned* bar; unsigned x; volatile LAS unsigned* st; };
__device__ __forceinline__ XcdBarrier xcd_barrier_post(unsigned* bar, volatile LAS unsigned* st) {
    XcdBarrier b; b.bar = bar; b.x = xb_xcc_id(); b.st = st;
    if (threadIdx.x == 0) (void)xb_add(&bar[XB_XCNT(b.x)], 1u);
    return b;
}
__device__ __forceinline__ void xcd_barrier_complete(unsigned* bar, unsigned x, unsigned& nloc, unsigned& nx) {
    const unsigned G = gridDim.x * gridDim.y * gridDim.z;
    unsigned sum, cnt, mine, sp = 0u;
    for (;;) {
        sum = 0u; cnt = 0u; mine = 0u;
#pragma unroll
        for (unsigned j = 0; j < 16; ++j) { const unsigned c = xb_ld(&bar[XB_XCNT(j)]); sum += c; cnt += (c > 0u) ? 1u : 0u; mine = (j == x) ? c : mine; }
        if (sum == G) break;
        __builtin_amdgcn_s_sleep(1);
        if ((++sp & 255u) == 0u) { if (xb_ld(&bar[XB_TMO])) break; if (sp > XB_SPIN_CAP) { atomicAdd(&bar[XB_TMO], 1u); break; } }
    }
    nloc = mine > 0u ? mine : 1u; nx = cnt > 0u ? cnt : 1u;
}
__device__ __forceinline__ void xcd_barrier(const XcdBarrier& b) {
    asm volatile("s_waitcnt vmcnt(0)" ::: "memory");
    __syncthreads();
    if (threadIdx.x == 0) {
        unsigned* bar = b.bar;
        __builtin_amdgcn_s_waitcnt(0);
        unsigned nloc = b.st[0], nx = b.st[1];
        if (nloc == 0u) { xcd_barrier_complete(bar, b.x, nloc, nx); b.st[0] = nloc; b.st[1] = nx; }
        const unsigned old = xb_add(&bar[XB_XSUB(b.x)], 1u);
        const unsigned gen = old / nloc;
        if (old + 1u == (gen + 1u) * nloc) {
            __builtin_amdgcn_fence(__ATOMIC_RELEASE, "agent");
            asm volatile("s_waitcnt vmcnt(0)" ::: "memory");
            const unsigned og = xb_add(&bar[XB_TOP], 1u);
            const unsigned tg = og / nx;
            if (og + 1u == (tg + 1u) * nx) xb_add(&bar[XB_TOPGEN], 1u);
            else XB_SPIN(xb_ld(&bar[XB_TOPGEN]) == tg, bar);
            __builtin_amdgcn_fence(__ATOMIC_ACQUIRE, "agent");
            xb_add(&bar[XB_XGEN(b.x)], 1u);
            asm volatile("s_waitcnt vmcnt(0)" ::: "memory");
        } else {
            XB_SPIN(xb_ld(&bar[XB_XGEN(b.x)]) == gen, bar);
            __builtin_amdgcn_fence(__ATOMIC_ACQUIRE, "agent");
            asm volatile("s_waitcnt vmcnt(0)" ::: "memory");
        }
    }
    __syncthreads();
}

struct Params {
    const float* x; const int* pos; const float* norm_g; const float* w1; const float* w3; const float* w2; const float* w_in; const float* conv_w;
    const float* pool_w; const float* pool_scale; const float* w_out; const float* w_qkv; const float* w_o; const float* final_g;
    float* out; unsigned char* ws;
    InvFreq inv;
    int ph_lo, ph_hi;
};
constexpr int LDS_BYTES = ATT_LDS + 16;
constexpr int NPHASE = 19;

__global__ void __launch_bounds__(NTHR, 2) mega_fwd(Params p) {
    extern __shared__ __attribute__((aligned(16))) unsigned char lds_raw[];
    LAS unsigned char* lds = (LAS unsigned char*)lds_raw;
    const int G = gridDim.x, bid = blockIdx.x;
    unsigned char* ws = p.ws;
    bf16_t* W13 = (bf16_t*)(ws + WS_W13); bf16_t* W2 = (bf16_t*)(ws + WS_W2); bf16_t* WA = (bf16_t*)(ws + WS_WA); bf16_t* WB = (bf16_t*)(ws + WS_WB);
    bf16_t* POOLW = (bf16_t*)(ws + WS_POOLW); float* ROPE = (float*)(ws + WS_ROPE); bf16_t* XN = (bf16_t*)(ws + WS_XN); bf16_t* BIG = (bf16_t*)(ws + WS_BIG);
    bf16_t* OG = (bf16_t*)(ws + WS_OG); bf16_t* POOLED = (bf16_t*)(ws + WS_OG); float* LSE = (float*)(ws + WS_LSE);
    float* H = p.out;
    const int lo = p.ph_lo, hi = p.ph_hi;
    volatile LAS unsigned* bst = (volatile LAS unsigned*)(lds + ATT_LDS);
    if (threadIdx.x < 4) bst[threadIdx.x] = 0u;
    __syncthreads();
    XcdBarrier xbar; xbar.bar = (unsigned*)(ws + WS_BAR); xbar.x = 0; xbar.st = bst;
    if (hi - lo > 1) xbar = xcd_barrier_post((unsigned*)(ws + WS_BAR), bst);
    if (lo < 0) cg::this_grid().sync();
#define IN(k) (lo <= (k) && (k) < hi)
#define SEAM(k) do { if (IN(k) && IN((k) + 1)) xcd_barrier(xbar); } while (0)
    const size_t WSZ = (size_t)DM * DFF;

    bf16_t* HB = (bf16_t*)(ws + WS_HB); float* RS = (float*)(ws + WS_RS);
    const float* NG = p.norm_g;
    if (IN(0)) {
        convert_w((LAS float*)lds, p.w2, DFF, DM, W2, 0, 0, nullptr, G, bid);
        convert_w((LAS float*)lds, p.w1, DM, DFF, W13, 1, 0, NG, G, bid);
        convert_w((LAS float*)lds, p.w3, DM, DFF, W13, 1, 1, NG, G, bid);
        rope_phase(p.pos, p.inv, ROPE, G, bid);
        cast_phase(p.x, HB, RS, G, bid);
    }
    SEAM(0);
    if (IN(1)) { Gemm g{HB, W13, DM, DM, SEQ, 2 * DFF, DM, 0}; StaticOrder S; S.init(SEQ, 2 * DFF, G, bid); EpiSwiglu E{BIG, DFF, RS + 0 * SEQ}; gemm_phase(lds, g, S, E); }
    SEAM(1);
    if (IN(2)) { Gemm g{BIG, W2, DFF, DFF, SEQ, DM, DFF, 0, 1}; StaticOrder S; S.init(SEQ, DM, G, bid, 4); EpiResid<true, 1> E{RS}; gemm_phase(lds, g, S, E); }
    if (IN(2)) convert_w((LAS float*)lds, p.w_in, DM, 4096, WA, 0, 0, NG + 1 * DM, G, bid);
    SEAM(2);
    if (IN(3)) { Gemm g{HB, WA, DM, DM, SEQ, 4096, DM, 0}; StaticOrder S; S.init(SEQ, 4096, G, bid); EpiBf16 E{BIG, 4096, nullptr, RS + 1 * SEQ}; gemm_phase(lds, g, S, E); }
    SEAM(3);
    if (IN(4)) convpool_phase(BIG, p.conv_w, XN, POOLED, G, bid);
    if (IN(4)) {
        convert_w((LAS float*)lds, p.w_out, DM, DM, WB, 0, 0, nullptr, G, bid);
        for (int gq = 0; gq < 4; ++gq) convert_w((LAS float*)lds, p.pool_w + (size_t)gq * 65536, 256, 256, POOLW + (size_t)gq * 65536, 0, 0, nullptr, G, bid);
    }
    SEAM(4);
    if (IN(5)) { Gemm g{POOLED, POOLW, 1024, 256, SEQ, 1024, 256, 512}; StaticOrder S; S.init(SEQ, 1024, G, bid); EpiBf16 E{XN + 1024, DM, p.pool_scale, nullptr}; gemm_phase(lds, g, S, E); }
    SEAM(5);
    if (IN(6)) { Gemm g{XN, WB, DM, DM, SEQ, DM, DM, 0}; StaticOrder S; S.init(SEQ, DM, G, bid, 4); EpiResid<false, 2> E{RS}; gemm_phase(lds, g, S, E); }
    if (IN(6)) {
        convert_w((LAS float*)lds, p.w2 + (size_t)1 * WSZ, DFF, DM, W2 + (size_t)DM * DFF, 0, 0, nullptr, G, bid);
        convert_w((LAS float*)lds, p.w1 + (size_t)1 * WSZ, DM, DFF, W13 + (size_t)2 * DFF * DM, 1, 0, NG + 2 * DM, G, bid);
        convert_w((LAS float*)lds, p.w3 + (size_t)1 * WSZ, DM, DFF, W13 + (size_t)2 * DFF * DM, 1, 1, NG + 2 * DM, G, bid);
    }
    SEAM(6);
    if (IN(7)) { Gemm g{HB, W13 + (size_t)2 * DFF * DM, DM, DM, SEQ, 2 * DFF, DM, 0}; StaticOrder S; S.init(SEQ, 2 * DFF, G, bid); EpiSwiglu E{BIG, DFF, RS + 2 * SEQ}; gemm_phase(lds, g, S, E); }
    SEAM(7);
    if (IN(8)) { Gemm g{BIG, W2 + (size_t)DM * DFF, DFF, DFF, SEQ, DM, DFF, 0, 1}; StaticOrder S; S.init(SEQ, DM, G, bid, 4); EpiResid<true, 3> E{RS}; gemm_phase(lds, g, S, E); }
    if (IN(8)) {
        convert_w((LAS float*)lds, p.w2 + (size_t)2 * WSZ, DFF, DM, W2, 0, 0, nullptr, G, bid);
        convert_w((LAS float*)lds, p.w1 + (size_t)2 * WSZ, DM, DFF, W13, 1, 0, NG + 3 * DM, G, bid);
        convert_w((LAS float*)lds, p.w3 + (size_t)2 * WSZ, DM, DFF, W13, 1, 1, NG + 3 * DM, G, bid);
    }
    SEAM(8);
    if (IN(10)) { Gemm g{HB, W13, DM, DM, SEQ, 2 * DFF, DM, 0}; StaticOrder S; S.init(SEQ, 2 * DFF, G, bid); EpiSwiglu E{BIG, DFF, RS + 3 * SEQ}; gemm_phase(lds, g, S, E); }
    SEAM(10);
    if (IN(11)) { Gemm g{BIG, W2, DFF, DFF, SEQ, DM, DFF, 0, 1}; StaticOrder S; S.init(SEQ, DM, G, bid, 4); EpiResid<true, 4> E{RS}; gemm_phase(lds, g, S, E); }
    if (IN(11)) convert_w((LAS float*)lds, p.w_qkv, DM, 6144, WA, 2, 0, NG + 4 * DM, G, bid);
    SEAM(11);
    if (IN(12)) { Gemm g{HB, WA, DM, DM, SEQ, 6144, DM, 0}; StaticOrder S; S.init(SEQ, 6144, G, bid); EpiQkv E{BIG, 6144, ROPE, RS + 4 * SEQ}; gemm_phase(lds, g, S, E); }
    SEAM(12);
    if (IN(13)) attn_phase(lds, BIG, OG, LSE, G, bid);
    SEAM(13);
    if (IN(14)) combine_phase(OG, LSE, XN, G, bid);
    if (IN(14)) convert_w((LAS float*)lds, p.w_o, DM, DM, WB, 0, 0, nullptr, G, bid);
    SEAM(14);
    if (IN(15)) { Gemm g{XN, WB, DM, DM, SEQ, DM, DM, 0}; StaticOrder S; S.init(SEQ, DM, G, bid, 4); EpiResid<false, 5> E{RS}; gemm_phase(lds, g, S, E); }
    if (IN(15)) {
        convert_w((LAS float*)lds, p.w2 + (size_t)3 * WSZ, DFF, DM, W2 + (size_t)DM * DFF, 0, 0, nullptr, G, bid);
        convert_w((LAS float*)lds, p.w1 + (size_t)3 * WSZ, DM, DFF, W13 + (size_t)2 * DFF * DM, 1, 0, NG + 5 * DM, G, bid);
        convert_w((LAS float*)lds, p.w3 + (size_t)3 * WSZ, DM, DFF, W13 + (size_t)2 * DFF * DM, 1, 1, NG + 5 * DM, G, bid);
    }
    SEAM(15);
    if (IN(16)) { Gemm g{HB, W13 + (size_t)2 * DFF * DM, DM, DM, SEQ, 2 * DFF, DM, 0}; StaticOrder S; S.init(SEQ, 2 * DFF, G, bid); EpiSwiglu E{BIG, DFF, RS + 5 * SEQ}; gemm_phase(lds, g, S, E); }
    SEAM(16);
    if (IN(17)) { Gemm g{BIG, W2 + (size_t)DM * DFF, DFF, DFF, SEQ, DM, DFF, 0, 1}; StaticOrder S; S.init(SEQ, DM, G, bid, 4); EpiResid<true, 6> E{RS}; gemm_phase(lds, g, S, E); }
    SEAM(17);
    if (IN(18)) final_norm_phase(HB, p.final_g, RS + 6 * SEQ, H, G, bid);
#undef IN
#undef SEAM
}

extern "C" void kernel_launch(void* const* d_in, const int* in_sizes, int n_in, void* d_out, int out_size, void* d_ws, size_t ws_size, hipStream_t stream) {
    static int grid = 0;
    if (grid == 0) {
        if (n_in != 14 || out_size != SEQ * DM || ws_size < WS_END) { fprintf(stderr, "kernel_launch: unexpected shapes (n_in %d, out %d, ws %zu, need %zu)\n", n_in, out_size, ws_size, (size_t)WS_END); grid = -1; return; }
        int dev = 0, cus = 0, per_cu = 0;
        hipGetDevice(&dev);
        hipDeviceGetAttribute(&cus, hipDeviceAttributeMultiprocessorCount, dev);
        if (hipFuncSetAttribute((const void*)mega_fwd, hipFuncAttributeMaxDynamicSharedMemorySize, LDS_BYTES) != hipSuccess) { fprintf(stderr, "kernel_launch: hipFuncSetAttribute failed\n"); grid = -1; return; }
        if (hipOccupancyMaxActiveBlocksPerMultiprocessor(&per_cu, (const void*)mega_fwd, NTHR, LDS_BYTES) != hipSuccess || per_cu < 1) { fprintf(stderr, "kernel_launch: occupancy query gave %d\n", per_cu); per_cu = 1; }
        (void)hipGetLastError();
        grid = cus * 1;
    }
    if (grid < 0) return;
    Params p{};
    p.x = (const float*)d_in[0]; p.pos = (const int*)d_in[1]; p.norm_g = (const float*)d_in[2]; p.w1 = (const float*)d_in[3]; p.w3 = (const float*)d_in[4]; p.w2 = (const float*)d_in[5];
    p.w_in = (const float*)d_in[6]; p.conv_w = (const float*)d_in[7]; p.pool_w = (const float*)d_in[8]; p.pool_scale = (const float*)d_in[9]; p.w_out = (const float*)d_in[10];
    p.w_qkv = (const float*)d_in[11]; p.w_o = (const float*)d_in[12]; p.final_g = (const float*)d_in[13];
    p.out = (float*)d_out; p.ws = (unsigned char*)d_ws;
    for (int i = 0; i < 16; ++i) p.inv.v[i] = (float)std::pow(500000.0, -(double)(2 * i) / 32.0);
#if MK_PER_PHASE
    for (int k = 0; k < NPHASE; ++k) {
        p.ph_lo = k; p.ph_hi = k + 1;
        hipLaunchKernelGGL(mega_fwd, dim3(grid), dim3(NTHR), LDS_BYTES, stream, p);
    }
#else
    p.ph_lo = 0; p.ph_hi = NPHASE;
    if (hipMemsetAsync((unsigned char*)d_ws + WS_BAR, 0, BAR_BYTES, stream) != hipSuccess) { fprintf(stderr, "kernel_launch: memset of barrier words failed\n"); return; }
    void* args[] = {&p};
    hipError_t e = hipLaunchCooperativeKernel((const void*)mega_fwd, dim3(grid), dim3(NTHR), args, LDS_BYTES, stream);
    if (e != hipSuccess) fprintf(stderr, "kernel_launch: cooperative launch failed: %s (grid %d)\n", hipGetErrorString(e), grid);
#endif
}
```
